# Optimizing an MI355X kernel written in HIP

```python
import math
import jax, jax.numpy as jnp
from jax import lax
import numpy as np

D_MODEL = 1024
BATCH = 4
SEQ = 4096
DEPTH = 4
DEC_BATCH = 128
DEC_SEQ = 4
PAST_LEN = 8192
PAGE_SIZE = 128

MIX_WIDTH = D_MODEL
MEM_HEADS = 4
MEM_HEAD_DIM = 64
MEM_WIDTH = MEM_HEADS * MEM_HEAD_DIM
TOK_WIDTH = MIX_WIDTH - MEM_WIDTH
N_MEM = 256
HG_HEAD_DIM = 128
HG_HEADS = TOK_WIDTH // HG_HEAD_DIM
HG_CHUNK = 64
HG_IN = 4 * TOK_WIDTH + MEM_WIDTH
LB_MAX = 0.999
SW_HEAD_DIM = 64
SW_Q_HEADS = TOK_WIDTH // SW_HEAD_DIM
SW_KV_HEADS = 4
SW_GROUP = SW_Q_HEADS // SW_KV_HEADS
WINDOW = 128
SW_IN = (SW_Q_HEADS + 2 * SW_KV_HEADS) * SW_HEAD_DIM + MEM_WIDTH
D_FF = -(-8 * D_MODEL // (3 * 256)) * 256
N_HGRN = (DEPTH + 1) // 2
N_SWA = DEPTH // 2
EPS = 1e-6
NEG = -1e30

kernel_name = 'hgrn2_swa_sink_memory_hybrid_step'

F32 = jnp.float32


def rmsnorm(x, g):
    xf = x.astype(F32)
    y = xf * lax.rsqrt(jnp.mean(xf * xf, axis=-1, keepdims=True) + EPS) * g.astype(F32)
    return y.astype(x.dtype)


def head_rms(x, g):
    xf = x.astype(F32)
    return xf * lax.rsqrt(jnp.mean(xf * xf, axis=-1, keepdims=True) + EPS) * g.astype(F32)


def _chunk_len(L):
    return L if L <= HG_CHUNK else math.gcd(L, HG_CHUNK)


def hgrn_recurrence(q, k, v, logf, s0):
    b_, L, H, DK = q.shape
    DV = v.shape[-1]
    C = _chunk_len(L)
    n = L // C

    def to_chunks(t):
        return t.reshape(b_, n, C, H, t.shape[-1]).transpose(1, 0, 3, 2, 4)

    causal = jnp.tril(jnp.ones((C, C), bool))[:, :, None]

    def step(s, inp):
        qc, kc, vc, gc = inp
        cum = jnp.cumsum(gc, axis=2)
        diff = cum[:, :, :, None, :] - cum[:, :, None, :, :]
        decay = jnp.exp(jnp.where(causal, diff, NEG))
        att = jnp.einsum('bhtc,bhsc,bhtsc->bhts', qc, kc, decay)
        o = (jnp.einsum('bhts,bhsv->bhtv', att, vc)
             + jnp.einsum('bhtc,bhcv->bhtv', qc * jnp.exp(cum), s))
        last = cum[:, :, -1:, :]
        s_new = (jnp.exp(last[:, :, 0, :, None]) * s
                 + jnp.einsum('bhsc,bhsv->bhcv', kc * jnp.exp(last - cum), vc))
        return s_new, o

    s_fin, o = lax.scan(step, s0, (to_chunks(q), to_chunks(k), to_chunks(v), to_chunks(logf)))
    o = o.transpose(1, 0, 3, 2, 4).reshape(b_, L, H, DV)
    return o, s_fin


def hgrn_branch(p, lb, g_norm, s0):
    q, fz, i_in, g = jnp.split(p, 4, axis=-1)
    B, L, _ = q.shape
    shp = (B, L, HG_HEADS, HG_HEAD_DIM)
    qf = (jax.nn.silu(q.astype(F32)) * HG_HEAD_DIM ** -0.5).reshape(shp)
    z = fz.astype(F32)
    f = lb + (1.0 - lb) * jax.nn.sigmoid(z)
    logf = jnp.log(f).reshape(shp)
    kf = ((1.0 - lb) * jax.nn.sigmoid(-z)).reshape(shp)
    vf = i_in.astype(F32).reshape(shp)
    o, s = hgrn_recurrence(qf, kf, vf, logf, s0.astype(F32))
    o = head_rms(o, jnp.ones((HG_HEAD_DIM,), F32)).reshape(B, L, TOK_WIDTH)
    o = o * g_norm.astype(F32) * jax.nn.silu(g.astype(F32))
    return o, s


def sink_softmax(s, sinks):
    sk = sinks.astype(F32).reshape(SW_KV_HEADS, SW_GROUP, 1, 1)
    m = jnp.maximum(jnp.max(s, axis=-1, keepdims=True), sk)
    p = jnp.exp(s - m)
    return p / (jnp.sum(p, axis=-1, keepdims=True) + jnp.exp(sk - m))


def swa_prompt(q, k, v, sinks):
    B, L = q.shape[:2]
    n = L // WINDOW
    qb = q.reshape(B, n, WINDOW, SW_KV_HEADS, SW_GROUP, SW_HEAD_DIM)
    kb = k.reshape(B, n, WINDOW, SW_KV_HEADS, SW_HEAD_DIM)
    vb = v.reshape(B, n, WINDOW, SW_KV_HEADS, SW_HEAD_DIM)

    def with_prev(t):
        prev = jnp.pad(t[:, :-1], ((0, 0), (1, 0), (0, 0), (0, 0), (0, 0)))
        return jnp.concatenate([prev, t], axis=2)

    kk, vv = with_prev(kb), with_prev(vb)
    s = jnp.einsum('bnqkgd,bnskd->bnkgqs', qb, kk) * SW_HEAD_DIM ** -0.5
    qi = jnp.arange(WINDOW)[:, None]
    r = jnp.arange(2 * WINDOW)[None, :]
    band = (r > qi) & (r <= qi + WINDOW)
    has_prev = (jnp.arange(n)[:, None, None] > 0) | (r >= WINDOW)[None]
    mask = (band[None] & has_prev)[None, :, None, None]
    p = sink_softmax(jnp.where(mask, s, NEG), sinks)
    o = jnp.einsum('bnkgqs,bnskd->bnqkgd', p, vv)
    return o.reshape(B, L, SW_Q_HEADS * SW_HEAD_DIM)


def swa_sample(q, k, v, buf_k, buf_v, sinks):
    B, L = q.shape[:2]
    kk = jnp.concatenate([buf_k.astype(F32), k], axis=1)
    vv = jnp.concatenate([buf_v.astype(F32), v], axis=1)
    qg = q.reshape(B, L, SW_KV_HEADS, SW_GROUP, SW_HEAD_DIM)
    s = jnp.einsum('bqkgd,bskd->bkgqs', qg, kk) * SW_HEAD_DIM ** -0.5
    j = jnp.arange(L)[:, None]
    r = jnp.arange(WINDOW + L)[None, :]
    mask = (r > j) & (r <= j + WINDOW)
    p = sink_softmax(jnp.where(mask, s, NEG), sinks)
    o = jnp.einsum('bkgqs,bskd->bqkgd', p, vv).reshape(B, L, SW_Q_HEADS * SW_HEAD_DIM)
    return o, kk[:, -WINDOW:], vv[:, -WINDOW:]


def mem_kv(mem, norm_g, w_kv, k_norm):
    B = mem.shape[0]
    kv = rmsnorm(mem, norm_g) @ w_kv
    k, v = jnp.split(kv, 2, axis=-1)
    k = head_rms(k.reshape(B, N_MEM, MEM_HEADS, MEM_HEAD_DIM), k_norm)
    v = v.reshape(B, N_MEM, MEM_HEADS, MEM_HEAD_DIM).astype(F32)
    return k, v


def mem_attend(cq, mk, mv, q_norm):
    B, L, _ = cq.shape
    q = head_rms(cq.reshape(B, L, MEM_HEADS, MEM_HEAD_DIM), q_norm)
    s = jnp.einsum('blhd,bmhd->bhlm', q, mk.astype(F32)) * MEM_HEAD_DIM ** -0.5
    p = jax.nn.softmax(s, axis=-1)
    return jnp.einsum('bhlm,bmhd->blhd', p, mv.astype(F32)).reshape(B, L, MEM_WIDTH)


def setup_inputs(seed: int = 0) -> dict:
    key = jax.random.key(seed)
    ks = jax.random.split(key, 32)

    def nrm(k, shape, scale=1.0):
        return jax.random.normal(k, shape, F32) * scale

    def gain(k, shape):
        return 1.0 + 0.02 * jax.random.normal(k, shape, F32)

    out_scale = (2.0 * DEPTH) ** -0.5
    return {
        'x_prompt': nrm(ks[0], (BATCH, SEQ, D_MODEL)),
        'x_sample': nrm(ks[1], (DEC_BATCH, DEC_SEQ, D_MODEL)),
        'cache_mem_k': nrm(ks[2], (DEPTH, DEC_BATCH, N_MEM, MEM_HEADS, MEM_HEAD_DIM)),
        'cache_mem_v': nrm(ks[3], (DEPTH, DEC_BATCH, N_MEM, MEM_HEADS, MEM_HEAD_DIM)),
        'state_hgrn': nrm(ks[4], (N_HGRN, DEC_BATCH, HG_HEADS, HG_HEAD_DIM, HG_HEAD_DIM), 0.5),
        'cache_swa_k': nrm(ks[5], (N_SWA, DEC_BATCH, WINDOW, SW_KV_HEADS, SW_HEAD_DIM)),
        'cache_swa_v': nrm(ks[6], (N_SWA, DEC_BATCH, WINDOW, SW_KV_HEADS, SW_HEAD_DIM)),
        'mem_prompt': nrm(ks[7], (BATCH, N_MEM, D_MODEL)),
        'norm_mix': gain(ks[8], (DEPTH, D_MODEL)),
        'norm_ffn': gain(ks[9], (DEPTH, D_MODEL)),
        'norm_mem': gain(ks[10], (DEPTH, D_MODEL)),
        'w_in_hgrn': nrm(ks[11], (N_HGRN, D_MODEL, HG_IN), D_MODEL ** -0.5),
        'hgrn_lb_raw': 1.0 + 0.1 * nrm(ks[12], (N_HGRN, TOK_WIDTH)),
        'hgrn_out_norm': gain(ks[13], (N_HGRN, TOK_WIDTH)),
        'w_in_swa': nrm(ks[14], (N_SWA, D_MODEL, SW_IN), D_MODEL ** -0.5),
        'swa_q_norm': gain(ks[15], (N_SWA, SW_HEAD_DIM)),
        'swa_k_norm': gain(ks[16], (N_SWA, SW_HEAD_DIM)),
        'swa_sinks': nrm(ks[17], (N_SWA, SW_Q_HEADS), 0.5),
        'w_mem_kv': nrm(ks[18], (DEPTH, D_MODEL, 2 * MEM_WIDTH), D_MODEL ** -0.5),
        'mem_q_norm': gain(ks[19], (DEPTH, MEM_HEAD_DIM)),
        'mem_k_norm': gain(ks[20], (DEPTH, MEM_HEAD_DIM)),
        'w_out': nrm(ks[21], (DEPTH, MIX_WIDTH, D_MODEL), MIX_WIDTH ** -0.5 * out_scale),
        'w_ffn_in': nrm(ks[22], (DEPTH, D_MODEL, 2 * D_FF), D_MODEL ** -0.5),
        'w_ffn_out': nrm(ks[23], (DEPTH, D_FF, D_MODEL), D_FF ** -0.5 * out_scale),
    }


def reference(x_prompt, x_sample, cache_mem_k, cache_mem_v, state_hgrn, cache_swa_k, cache_swa_v,
              mem_prompt, norm_mix, norm_ffn, norm_mem, w_in_hgrn, hgrn_lb_raw, hgrn_out_norm,
              w_in_swa, swa_q_norm, swa_k_norm, swa_sinks, w_mem_kv, mem_q_norm, mem_k_norm,
              w_out, w_ffn_in, w_ffn_out):
    sm = jax.nn.softmax(hgrn_lb_raw.astype(F32), axis=0)
    lbs = jnp.clip(jnp.cumsum(sm, axis=0) - sm[0], 0.0, LB_MAX)

    def layer(x, i, mk, mv, hg_s0, buf_k, buf_v):
        dt = x.dtype
        B, L, _ = x.shape
        j = i // 2
        h = rmsnorm(x, norm_mix[i])
        if i % 2 == 0:
            p = h @ w_in_hgrn[j]
            tok, st = hgrn_branch(p[..., :4 * TOK_WIDTH], lbs[j], hgrn_out_norm[j], hg_s0)
            new_a, new_b = st.astype(dt), None
            cq = p[..., 4 * TOK_WIDTH:]
        else:
            p = h @ w_in_swa[j]
            nq = SW_Q_HEADS * SW_HEAD_DIM
            nk = SW_KV_HEADS * SW_HEAD_DIM
            q = head_rms(p[..., :nq].reshape(B, L, SW_Q_HEADS, SW_HEAD_DIM), swa_q_norm[j])
            k = head_rms(p[..., nq:nq + nk].reshape(B, L, SW_KV_HEADS, SW_HEAD_DIM), swa_k_norm[j])
            v = p[..., nq + nk:nq + 2 * nk].reshape(B, L, SW_KV_HEADS, SW_HEAD_DIM).astype(F32)
            cq = p[..., nq + 2 * nk:]
            if buf_k is None:
                tok = swa_prompt(q, k, v, swa_sinks[j])
                kb, vb = k[:, -WINDOW:], v[:, -WINDOW:]
            else:
                tok, kb, vb = swa_sample(q, k, v, buf_k, buf_v, swa_sinks[j])
            new_a, new_b = kb.astype(dt), vb.astype(dt)
        mo = mem_attend(cq, mk, mv, mem_q_norm[i])
        x = x + jnp.concatenate([tok.astype(dt), mo.astype(dt)], axis=-1) @ w_out[i]
        gu = rmsnorm(x, norm_ffn[i]) @ w_ffn_in[i]
        g, u = jnp.split(gu, 2, axis=-1)
        x = x + (jax.nn.silu(g) * u) @ w_ffn_out[i]
        return x, new_a, new_b

    dt = x_prompt.dtype
    xp, xs = x_prompt, x_sample
    mk_p, mv_p, hg_p, hg_s, swk_p, swv_p, swk_s, swv_s = [], [], [], [], [], [], [], []
    for i in range(DEPTH):
        j = i // 2
        mkp, mvp = mem_kv(mem_prompt, norm_mem[i], w_mem_kv[i], mem_k_norm[i])
        mk_p.append(mkp.astype(dt))
        mv_p.append(mvp.astype(dt))
        if i % 2 == 0:
            s0 = jnp.zeros((xp.shape[0], HG_HEADS, HG_HEAD_DIM, HG_HEAD_DIM), F32)
            xp, a, _ = layer(xp, i, mkp, mvp, s0, None, None)
            xs, b, _ = layer(xs, i, cache_mem_k[i], cache_mem_v[i], state_hgrn[j], None, None)
            hg_p.append(a)
            hg_s.append(b)
        else:
            xp, kp, vp = layer(xp, i, mkp, mvp, None, None, None)
            xs, ksm, vsm = layer(xs, i, cache_mem_k[i], cache_mem_v[i], None, cache_swa_k[j], cache_swa_v[j])
            swk_p.append(kp)
            swv_p.append(vp)
            swk_s.append(ksm)
            swv_s.append(vsm)

    new_mem_k_prompt = jnp.stack(mk_p)
    new_mem_v_prompt = jnp.stack(mv_p)
    new_hgrn_prompt = jnp.stack(hg_p)
    new_hgrn_sample = jnp.stack(hg_s)
    new_swa_k_prompt = jnp.stack(swk_p)
    new_swa_v_prompt = jnp.stack(swv_p)
    new_swa_k_sample = jnp.stack(swk_s)
    new_swa_v_sample = jnp.stack(swv_s)
    return (xp, xs, new_mem_k_prompt, new_mem_v_prompt, new_hgrn_prompt, new_hgrn_sample,
            new_swa_k_prompt, new_swa_v_prompt, new_swa_k_sample, new_swa_v_sample)
```

```cpp
#include <hip/hip_runtime.h>
#include <cstdio>
#include <cstdint>
namespace pg8 {
#define PG8_LAS __attribute__((address_space(3)))
typedef unsigned short bf16_t;
typedef short bf16x8 __attribute__((ext_vector_type(8)));
typedef float f32x4 __attribute__((ext_vector_type(4)));
typedef unsigned u32x4 __attribute__((ext_vector_type(4)));
constexpr int BM = 256, BK = 64, HALF = 128, HTB = HALF * BK * 2  , STAGE_BYTES = 8 * HTB, NXCD = 8, WGM = 8;

__host__ __device__ __forceinline__ int lds_byte(int r, int c) { const int st = (r >> 4) * 2 + (c >> 5), rr = r & 15, cc = c & 31, ob = rr * 64 + cc * 2; return st * 1024 + (ob ^ (((ob >> 9) & 1) << 5)); }
__host__ __device__ __forceinline__ void stage_rc(int b, int& R, int& C) { const int st = b / 1024, sb = b % 1024, swz = sb ^ (((sb >> 9) & 1) << 5); R = (st >> 1) * 16 + swz / 64; C = (st & 1) * 32 + (swz % 64) / 2; }
__host__ __device__ __forceinline__ int perm32(int rho) { const int n = rho >> 4, i = rho & 15; return 8 * (i >> 2) + 4 * n + (i & 3); }

struct Unit { int pm, pn; };
struct Gemm { const bf16_t* A; const bf16_t* Bt; int M, N, K; };

struct StaticOrder {
    int nM, nN, nwg, G, c;
    __host__ __device__ void init(int M, int N, int G_, int c_) { nM = M / BM; nN = N / BM; nwg = nM * nN; G = G_; c = c_; }
    __host__ __device__ bool next(int i, Unit& u) const {
        const long L = (long)i * G + c; if (L >= nwg) return false;
        int wgid = (int)L; { const int q = nwg / NXCD, r = nwg % NXCD, xcd = wgid % NXCD, off = wgid / NXCD; wgid = (xcd < r ? xcd * (q + 1) : r * (q + 1) + (xcd - r) * q) + off; }
        const int nig = WGM * nN, gid = wgid / nig, fm = gid * WGM, gsz = (nM - fm) < WGM ? (nM - fm) : WGM;
        u.pm = fm + ((wgid % nig) % gsz); u.pn = (wgid % nig) / gsz; return true;
    }
    __device__ __forceinline__ void a_ready(const Unit&) const {}
    __device__ __forceinline__ void done(const Unit&) const {}
};
template <class Epi, class Sched, bool ALIGN_EPI = false, bool SP2 = false>
__device__ __forceinline__ void gemm_phase(PG8_LAS unsigned char* lds, const Gemm g, const Sched& S, const Epi& E, const int tid) {
    const int wid = __builtin_amdgcn_readfirstlane(tid >> 6), lane = tid & 63, wr = wid >> 2, wc = wid & 3, fr = lane & 15, fq = lane >> 4;
    const int K = g.K, nt = K / BK;
    unsigned voffA[2], voffB[2];
#pragma unroll
    for (int i = 0; i < 2; ++i) { int R, C; stage_rc(tid * 16 + i * 8192, R, C); const int Rb = Epi::PERM ? ((R & ~31) + perm32(R & 31)) : R;
        voffA[i] = (unsigned)(R * K + C) * 2u; voffB[i] = (unsigned)(Rb * K + C) * 2u; }
    const size_t kstep = (size_t)(BK * 2);
    const size_t hstep = (size_t)HALF * K * 2;
    const size_t tstep = 2 * hstep;
    const unsigned ldsw = (unsigned)wid * 1024u;
    const int aoff = lds_byte(wr * 64 + fr, fq * 8), boff = lds_byte(wc * 32 + fr, fq * 8);
#define PG8_SA(b, h) (((b) * 2 + (h)) * HTB)
#define PG8_SB(b, h) ((4 + (b) * 2 + (h)) * HTB)
#define PG8_STAGE(bufoff, gbase, voff) do { _Pragma("unroll") for (int _i = 0; _i < 2; ++_i) \
        __builtin_amdgcn_global_load_lds((const unsigned*)((const char*)(gbase) + (voff)[_i]), (PG8_LAS unsigned*)(lds + (bufoff) + ldsw + _i * 8192), 16, 0, 0); } while (0)
#define PG8_LDA(dst, b, h) do { _Pragma("unroll") for (int m = 0; m < 4; ++m) _Pragma("unroll") for (int k = 0; k < 2; ++k) dst[m][k] = *(const PG8_LAS bf16x8*)(lds + PG8_SA(b, h) + aoff + m * 2048 + k * 1024); } while (0)
#define PG8_LDB(dst, b, h) do { _Pragma("unroll") for (int n = 0; n < 2; ++n) _Pragma("unroll") for (int k = 0; k < 2; ++k) dst[n][k] = *(const PG8_LAS bf16x8*)(lds + PG8_SB(b, h) + boff + n * 2048 + k * 1024); } while (0)
#define PG8_MMA(ai, bj, At, Bt) do { __builtin_amdgcn_s_setprio(1); _Pragma("unroll") for (int m = 0; m < 4; ++m) _Pragma("unroll") for (int n = 0; n < 2; ++n) _Pragma("unroll") for (int k = 0; k < 2; ++k) \
        acc[ai][bj][m][n] = __builtin_amdgcn_mfma_f32_16x16x32_bf16(Bt[n][k], At[m][k], acc[ai][bj][m][n], 0, 0, 0); __builtin_amdgcn_s_setprio(0); } while (0)
#define PG8_WAIT_V(n) asm volatile("s_waitcnt vmcnt(" #n ")" ::: "memory")
#define PG8_WAIT_L(n) asm volatile("s_waitcnt lgkmcnt(" #n ")" ::: "memory")
#define PG8_BAR __builtin_amdgcn_s_barrier()
#define PG8_SCHED __builtin_amdgcn_sched_barrier(0)
    Unit cur, nxt; int ui = 0;
    if (!S.next(0, cur)) return;
    f32x4 acc[2][2][4][2];
#pragma unroll
    for (int a = 0; a < 2; ++a)
#pragma unroll
        for (int b = 0; b < 2; ++b)
#pragma unroll
            for (int m = 0; m < 4; ++m)
#pragma unroll
                for (int n = 0; n < 2; ++n) acc[a][b][m][n] = (f32x4){0.f, 0.f, 0.f, 0.f};
    bf16x8 At[4][2], B0[2][2], B1[2][2];
    const char* cA = (const char*)g.A + (size_t)cur.pm * tstep; const char* cB = (const char*)g.Bt + (size_t)cur.pn * tstep;
    S.a_ready(cur);
    if constexpr (SP2) {
        PG8_STAGE(PG8_SB(0, 0), cB, voffB); PG8_STAGE(PG8_SB(0, 1), cB + hstep, voffB); PG8_STAGE(PG8_SA(0, 0), cA, voffA); PG8_STAGE(PG8_SA(0, 1), cA + hstep, voffA);
        if (wr == 1) PG8_BAR;
        PG8_WAIT_V(2); PG8_BAR;
        PG8_STAGE(PG8_SB(1, 0), cB + kstep, voffB); PG8_STAGE(PG8_SA(1, 0), cA + kstep, voffA); PG8_STAGE(PG8_SB(1, 1), cB + hstep + kstep, voffB);
        PG8_WAIT_V(6); PG8_BAR;
    } else {
        PG8_STAGE(PG8_SB(0, 0), cB, voffB); PG8_STAGE(PG8_SA(0, 0), cA, voffA); PG8_STAGE(PG8_SB(0, 1), cB + hstep, voffB); PG8_STAGE(PG8_SA(0, 1), cA + hstep, voffA);
        if (wr == 1) PG8_BAR;
        PG8_WAIT_V(4); PG8_BAR;
        PG8_STAGE(PG8_SB(1, 0), cB + kstep, voffB); PG8_STAGE(PG8_SA(1, 0), cA + kstep, voffA); PG8_STAGE(PG8_SB(1, 1), cB + hstep + kstep, voffB);
        PG8_WAIT_V(6); PG8_BAR;
    }
    for (;;) {
        const bool has_next = S.next(ui + 1, nxt);
        const char* nA = has_next ? (const char*)g.A + (size_t)nxt.pm * tstep : cA; const char* nB = has_next ? (const char*)g.Bt + (size_t)nxt.pn * tstep : cB;
        for (int t = 0; t < nt; t += 2) {
            const bool last = (t == nt - 2);
            const char* a1 = cA + (size_t)(t + 1) * kstep;
            const char* a2 = last ? nA : cA + (size_t)(t + 2) * kstep; const char* b2 = last ? nB : cB + (size_t)(t + 2) * kstep;
            const char* a3 = a2 + kstep; const char* b3 = b2 + kstep;
            if (last && has_next) S.a_ready(nxt);
            if constexpr (SP2) {
            PG8_LDB(B0, 0, 0); PG8_LDB(B1, 0, 1); PG8_SCHED; PG8_LDA(At, 0, 0); PG8_STAGE(PG8_SA(1, 1), a1 + hstep, voffA);
            PG8_WAIT_V(8); PG8_WAIT_L(0); PG8_BAR; PG8_MMA(0, 0, At, B0); PG8_MMA(0, 1, At, B1); PG8_BAR; PG8_SCHED;
            PG8_LDA(At, 0, 1); PG8_STAGE(PG8_SB(0, 0), b2, voffB); PG8_STAGE(PG8_SB(0, 1), b2 + hstep, voffB); PG8_STAGE(PG8_SA(0, 0), a2, voffA);
            PG8_WAIT_V(8); PG8_WAIT_L(0); PG8_BAR; PG8_MMA(1, 0, At, B0); PG8_MMA(1, 1, At, B1); PG8_BAR; PG8_SCHED;
            PG8_LDB(B0, 1, 0); PG8_LDB(B1, 1, 1); PG8_SCHED; PG8_LDA(At, 1, 0); PG8_STAGE(PG8_SA(0, 1), a2 + hstep, voffA);
            PG8_WAIT_V(8); PG8_WAIT_L(0); PG8_BAR; PG8_MMA(0, 0, At, B0); PG8_MMA(0, 1, At, B1); PG8_BAR; PG8_SCHED;
            PG8_LDA(At, 1, 1); PG8_STAGE(PG8_SB(1, 0), b3, voffB); PG8_STAGE(PG8_SB(1, 1), b3 + hstep, voffB); PG8_STAGE(PG8_SA(1, 0), a3, voffA);
            PG8_WAIT_V(8); PG8_WAIT_L(0); PG8_BAR; PG8_MMA(1, 0, At, B0); PG8_MMA(1, 1, At, B1); PG8_BAR; PG8_SCHED;
            } else {
            PG8_LDB(B0, 0, 0); PG8_SCHED; PG8_LDA(At, 0, 0); PG8_STAGE(PG8_SA(1, 1), a1 + hstep, voffA);
            PG8_WAIT_L(8); PG8_BAR; PG8_WAIT_L(0); PG8_MMA(0, 0, At, B0); PG8_BAR; PG8_SCHED;
            PG8_LDB(B1, 0, 1); PG8_STAGE(PG8_SB(0, 0), b2, voffB);
            PG8_BAR; PG8_WAIT_L(0); PG8_MMA(0, 1, At, B1); PG8_BAR;
            PG8_LDA(At, 0, 1); PG8_STAGE(PG8_SA(0, 0), a2, voffA);
            PG8_BAR; PG8_WAIT_L(0); PG8_MMA(1, 0, At, B0); PG8_BAR; PG8_SCHED;
            PG8_STAGE(PG8_SB(0, 1), b2 + hstep, voffB);
            PG8_WAIT_V(6); PG8_BAR; PG8_MMA(1, 1, At, B1); PG8_BAR;
            PG8_LDB(B0, 1, 0); PG8_SCHED; PG8_LDA(At, 1, 0); PG8_STAGE(PG8_SA(0, 1), a2 + hstep, voffA);
            PG8_WAIT_L(8); PG8_BAR; PG8_WAIT_L(0); PG8_MMA(0, 0, At, B0); PG8_BAR; PG8_SCHED;
            PG8_LDB(B1, 1, 1); PG8_STAGE(PG8_SB(1, 0), b3, voffB);
            PG8_BAR; PG8_WAIT_L(0); PG8_MMA(0, 1, At, B1); PG8_BAR;
            PG8_LDA(At, 1, 1); PG8_STAGE(PG8_SA(1, 0), a3, voffA);
            PG8_BAR; PG8_WAIT_L(0); PG8_MMA(1, 0, At, B0); PG8_BAR; PG8_SCHED;
            PG8_STAGE(PG8_SB(1, 1), b3 + hstep, voffB);
            PG8_WAIT_V(6); PG8_BAR; PG8_MMA(1, 1, At, B1); PG8_BAR;
            }
        }
        if constexpr (ALIGN_EPI) { if (wr == 0) PG8_BAR; }
        if constexpr (!Epi::AFTER_DRAIN) { E(acc, cur, wr, wc, fr, fq); S.done(cur); }
        if (!has_next) break;
#pragma unroll
        for (int a = 0; a < 2; ++a)
#pragma unroll
            for (int b = 0; b < 2; ++b)
#pragma unroll
                for (int m = 0; m < 4; ++m)
#pragma unroll
                    for (int n = 0; n < 2; ++n) acc[a][b][m][n] = (f32x4){0.f, 0.f, 0.f, 0.f};
        cur = nxt; cA = nA; cB = nB; ++ui;
        if constexpr (ALIGN_EPI) { if (wr == 1) PG8_BAR; }
    }
    PG8_WAIT_V(0);
    if constexpr (!ALIGN_EPI) { if (wr == 0) PG8_BAR; }
    PG8_BAR;
    if constexpr (Epi::AFTER_DRAIN) { E.fused(acc, cur, wr, wc, fr, fq, lds, wid, lane); S.done(cur); }
#undef PG8_SA
#undef PG8_SB
#undef PG8_STAGE
#undef PG8_LDA
#undef PG8_LDB
#undef PG8_MMA
#undef PG8_WAIT_V
#undef PG8_WAIT_L
#undef PG8_BAR
#undef PG8_SCHED
}
}
#define GAS __attribute__((address_space(1)))
#define LAS __attribute__((address_space(3)))
typedef unsigned short bf16;
typedef unsigned v4u __attribute__((ext_vector_type(4)));
typedef float f32x4 __attribute__((ext_vector_type(4)));
typedef short bf16x8 __attribute__((ext_vector_type(8)));
typedef GAS unsigned gu32;
typedef GAS unsigned long long gu64;
#define RLX_AGENT __ATOMIC_RELAXED, __HIP_MEMORY_SCOPE_AGENT
#define LDS_WAIT() asm volatile("s_waitcnt lgkmcnt(0)" ::: "memory")
#define VM_WAIT() asm volatile("s_waitcnt vmcnt(0)" ::: "memory")
__device__ __forceinline__ unsigned long long rt() { return __builtin_amdgcn_s_memrealtime(); }
__device__ __forceinline__ unsigned f2bf(float f) { unsigned u = __builtin_bit_cast(unsigned, f); return (u + 0x7fffu + ((u >> 16) & 1u)) >> 16; }
__device__ __forceinline__ unsigned pk2(float lo, float hi) { return f2bf(lo) | (f2bf(hi) << 16); }

#define XB_TMO      128
#define XB_XCNT(j)  (256  + 64 * (j))
#define XB_XSUB(j)  (1280 + 64 * (j))
#define XB_XGEN(j)  (2304 + 64 * (j))
#define XB_TOP      3328
#define XB_TOPGEN   3392
#define XCD_BAR_WORDS 3456
#define XB_SPIN_CAP (1u << 22)

__device__ __forceinline__ unsigned xb_ld(unsigned* p)              { return __hip_atomic_load(p, __ATOMIC_RELAXED, __HIP_MEMORY_SCOPE_AGENT); }
__device__ __forceinline__ unsigned xb_add(unsigned* p, unsigned v) { return __hip_atomic_fetch_add(p, v, __ATOMIC_RELAXED, __HIP_MEMORY_SCOPE_AGENT); }
__device__ __forceinline__ unsigned xb_xcc_id() { return (unsigned)__builtin_amdgcn_s_getreg((3 << 11) | 20) & 0xFu; }
#define XB_SPIN(cond, bar) do { unsigned _sp = 0; while (cond) { __builtin_amdgcn_s_sleep(1); \
    if ((++_sp & 255u) == 0u) { if (xb_ld(&(bar)[XB_TMO])) break; if (_sp > XB_SPIN_CAP) { atomicAdd(&(bar)[XB_TMO], 1u); break; } } } } while (0)

struct XcdBarrier {
    unsigned* bar; unsigned x;
    volatile LAS unsigned* st;
};

__device__ __forceinline__ XcdBarrier xcd_barrier_post(unsigned* bar, volatile LAS unsigned* st) {
    XcdBarrier b; b.bar = bar; b.x = xb_xcc_id(); b.st = st;
    if (threadIdx.x == 0) (void)xb_add(&bar[XB_XCNT(b.x)], 1u);
    return b;
}
__device__ __forceinline__ void xcd_barrier_complete(unsigned* bar, unsigned x, unsigned& nloc, unsigned& nx) {
    const unsigned G = gridDim.x * gridDim.y * gridDim.z;
    unsigned sum, cnt, mine, sp = 0u;
    for (;;) {
        sum = 0u; cnt = 0u; mine = 0u;
#pragma unroll
        for (unsigned j = 0; j < 16; ++j) { const unsigned c = xb_ld(&bar[XB_XCNT(j)]); sum += c; cnt += (c > 0u) ? 1u : 0u; mine = (j == x) ? c : mine; }
        if (sum == G) break;
        __builtin_amdgcn_s_sleep(1);
        if ((++sp & 255u) == 0u) { if (xb_ld(&bar[XB_TMO])) break; if (sp > XB_SPIN_CAP) { atomicAdd(&bar[XB_TMO], 1u); break; } }
    }
    nloc = mine > 0u ? mine : 1u; nx = cnt > 0u ? cnt : 1u;
}

__device__ __forceinline__ void xcd_barrier(const XcdBarrier& b) {
    asm volatile("s_waitcnt vmcnt(0)" ::: "memory");
    __syncthreads();
    if (threadIdx.x == 0) {
        unsigned* bar = b.bar;
        __builtin_amdgcn_s_waitcnt(0);
        unsigned nloc = b.st[0], nx = b.st[1];
        if (nloc == 0u) { xcd_barrier_complete(bar, b.x, nloc, nx); b.st[0] = nloc; b.st[1] = nx; }
        const unsigned old = xb_add(&bar[XB_XSUB(b.x)], 1u);
        const unsigned gen = old / nloc;
        if (old + 1u == (gen + 1u) * nloc) {
            __builtin_amdgcn_fence(__ATOMIC_RELEASE, "agent");
            asm volatile("s_waitcnt vmcnt(0)" ::: "memory");
            const unsigned og = xb_add(&bar[XB_TOP], 1u);
            const unsigned tg = og / nx;
            if (og + 1u == (tg + 1u) * nx) xb_add(&bar[XB_TOPGEN], 1u);
            else XB_SPIN(xb_ld(&bar[XB_TOPGEN]) == tg, bar);
            __builtin_amdgcn_fence(__ATOMIC_ACQUIRE, "agent");
            xb_add(&bar[XB_XGEN(b.x)], 1u);
            asm volatile("s_waitcnt vmcnt(0)" ::: "memory");
        } else {
            XB_SPIN(xb_ld(&bar[XB_XGEN(b.x)]) == gen, bar);
            __builtin_amdgcn_fence(__ATOMIC_ACQUIRE, "agent");
            asm volatile("s_waitcnt vmcnt(0)" ::: "memory");
        }
    }
    __syncthreads();
}

constexpr int D = 1024, SEQ = 4096, MP = 16384, MS = 512, M = MP + MS;
constexpr int TOKW = 768, MEMW = 256, HG_IN = 3328, SW_IN = 1536, DFF = 2816, NFF1 = 2 * DFF;
constexpr int NWAVES = 8, NTHR = 512;
constexpr float EPS = 1e-6f, LOG2E = 1.4426950408889634f;

constexpr size_t O_Y = 0, O_MK = 17301504, O_MV = 18350080, O_HGP = 19398656, O_HGS = 20185088, O_SKP = 45350912, O_SVP = 45613056, O_SKS = 45875200, O_SVS = 54263808;

constexpr size_t MiB = 1u << 20;
constexpr size_t WS_CTL = 0, CTL_ZERO_BYTES = 1 * MiB;
constexpr size_t WS_SMALL = 1 * MiB;
constexpr size_t WS_WINH = 2 * MiB, WS_WINS = 15 * MiB, WS_WMEM = 21 * MiB, WS_WOUT = 25 * MiB, WS_WFF1 = 33 * MiB, WS_WFF2 = 77 * MiB;
constexpr size_t WS_MEMB = 99 * MiB, WS_MK = 101 * MiB, WS_MV = 103 * MiB;
constexpr size_t WS_X = 105 * MiB, WS_XB = 171 * MiB, WS_ATT = 204 * MiB, WS_CQ = 237 * MiB;
constexpr size_t WS_P = 246 * MiB;
constexpr size_t P_SLAB = (size_t)M * 768 * 2;
constexpr size_t WS_U = 395 * MiB, WS_DD = 491 * MiB, WS_ST = 492 * MiB, WS_END = 540 * MiB;
static_assert(WS_P + 4 * P_SLAB + (size_t)M * 768 * 4 <= WS_U && WS_P + (size_t)M * DFF * 2 <= WS_U && WS_U + (size_t)1536 * 65536 <= WS_DD && WS_ST + (size_t)1536 * 32768 <= WS_END, "ws map");
static_assert(WS_X + (size_t)M * D * 4 <= WS_XB && WS_XB + (size_t)M * D * 2 <= WS_ATT && WS_ATT + (size_t)M * D * 2 <= WS_CQ && WS_CQ + (size_t)M * 256 * 2 <= WS_P, "ws map 2");
constexpr int CW_BAR = 4096;
constexpr int CW_SSQ = 32768;
static_assert((CW_SSQ + 8 * M) * 4 <= (int)CTL_ZERO_BYTES && CW_BAR + XCD_BAR_WORDS <= CW_SSQ, "ctl");

constexpr int RING_BYTES = 131072, MISC_OFF = RING_BYTES + 320, LDS_BYTES = 147456;

typedef float f32x16 __attribute__((ext_vector_type(16)));
typedef short s16x4 __attribute__((ext_vector_type(4)));
typedef float f32x2_t __attribute__((ext_vector_type(2)));
typedef __bf16 bf16x2_t __attribute__((ext_vector_type(2)));
typedef LAS unsigned char* ldsp;

__device__ __forceinline__ unsigned cpk(float lo, float hi) { f32x2_t v = {lo, hi}; bf16x2_t b = __builtin_convertvector(v, bf16x2_t); return __builtin_bit_cast(unsigned, b); }
__device__ __forceinline__ v4u cpk8(f32x4 a, f32x4 b) { v4u w; w.x = cpk(a[0], a[1]); w.y = cpk(a[2], a[3]); w.z = cpk(b[0], b[1]); w.w = cpk(b[2], b[3]); return w; }
__device__ __forceinline__ float bf2f(unsigned short x) { return __uint_as_float(((unsigned)x) << 16); }
__device__ __forceinline__ float fexp2(float x) { return __builtin_amdgcn_exp2f(x); }
__device__ __forceinline__ float fsigmoid(float z) { return __builtin_amdgcn_rcpf(1.0f + fexp2(-z * LOG2E)); }
__device__ __forceinline__ float fsilu(float z) { return z * fsigmoid(z); }
__device__ __forceinline__ float rms_r(const float* ssq, int row) { return __builtin_amdgcn_rsqf(ssq[row] * (1.0f / 1024.0f) + EPS); }
__device__ __forceinline__ float wave_sum(float v) {
#pragma unroll
    for (int o = 1; o < 64; o <<= 1) v += __shfl_xor(v, o);
    return v;
}
#define MFMA32(a, b, c) __builtin_amdgcn_mfma_f32_32x32x16_bf16((a), (b), (c), 0, 0, 0)
#define MFMA16(a, b, c) __builtin_amdgcn_mfma_f32_16x16x32_bf16((a), (b), (c), 0, 0, 0)
__device__ __forceinline__ s16x4 ldtr(LAS const unsigned char* p) { return __builtin_bit_cast(s16x4, __builtin_amdgcn_ds_read_tr16_b64_v4i16((LAS s16x4*)p)); }
__device__ __forceinline__ bf16x8 cat8(s16x4 lo, s16x4 hi) { return __builtin_shufflevector(lo, hi, 0, 1, 2, 3, 4, 5, 6, 7); }

using pg8::Unit;

struct EpiHG {
    static constexpr bool PERM = true, AFTER_DRAIN = false;
    const float* ssq; const float* pt;
    unsigned char* P; bf16* CQ;
    __device__ __forceinline__ void operator()(const f32x4 (&acc)[2][2][4][2], const Unit& u, int wr, int wc, int fr, int fq) const {
        const int row0 = u.pm * 256 + wr * 64 + fr, pn = u.pn;
        if (pn >= 12) {
            f32x4 g[2][2];
#pragma unroll
            for (int bj = 0; bj < 2; ++bj)
#pragma unroll
                for (int n = 0; n < 2; ++n) g[bj][n] = *(const f32x4*)(pt + 1536 + 32 * bj + 8 * fq + 4 * n);
#pragma unroll
            for (int ai = 0; ai < 2; ++ai)
#pragma unroll
                for (int m = 0; m < 4; ++m) {
                    const int row = row0 + ai * 128 + m * 16; const float r = rms_r(ssq, row);
                    f32x4 v[2][2]; float ss = 0.f;
#pragma unroll
                    for (int bj = 0; bj < 2; ++bj)
#pragma unroll
                        for (int n = 0; n < 2; ++n) { v[bj][n] = acc[ai][bj][m][n] * r; const f32x4 q = v[bj][n] * v[bj][n]; ss += (q[0] + q[1]) + (q[2] + q[3]); }
                    ss += __shfl_xor(ss, 16); ss += __shfl_xor(ss, 32);
                    const float rs = __builtin_amdgcn_rsqf(ss * (1.0f / 64.0f) + EPS);
#pragma unroll
                    for (int bj = 0; bj < 2; ++bj)
                        *(v4u*)(CQ + (size_t)row * 256 + wc * 64 + 32 * bj + 8 * fq) = cpk8(v[bj][0] * rs * g[bj][0], v[bj][1] * rs * g[bj][1]);
                }
            return;
        }
        const int typ = pn / 3, cb = (pn % 3) * 256 + wc * 32 + 8 * fq;
        bf16* const slab = (bf16*)(P + (size_t)typ * P_SLAB);
        float* const LFp = (float*)(P + 4 * P_SLAB);
        f32x4 pa[2][2];
#pragma unroll
        for (int bj = 0; bj < 2; ++bj)
#pragma unroll
            for (int n = 0; n < 2; ++n) pa[bj][n] = *(const f32x4*)(pt + (typ == 3 ? 768 : 0) + cb + bj * 128 + 4 * n);
#pragma unroll
        for (int ai = 0; ai < 2; ++ai)
#pragma unroll
            for (int m = 0; m < 4; ++m) {
                const int row = row0 + ai * 128 + m * 16; const float r = rms_r(ssq, row);
#pragma unroll
                for (int bj = 0; bj < 2; ++bj) {
                    const size_t off = (size_t)row * 768 + cb + bj * 128;
                    f32x4 v[2] = {acc[ai][bj][m][0] * r, acc[ai][bj][m][1] * r};
                    if (typ == 0) {
#pragma unroll
                        for (int n = 0; n < 2; ++n)
#pragma unroll
                            for (int e = 0; e < 4; ++e) v[n][e] = fsilu(v[n][e]) * 0.08838834764831845f;
                    } else if (typ == 1) {
                        f32x4 lf[2];
#pragma unroll
                        for (int n = 0; n < 2; ++n)
#pragma unroll
                            for (int e = 0; e < 4; ++e) {
                                const float z = v[n][e], l = pa[bj][n][e], sg = fsigmoid(z), f = l + (1.0f - l) * sg;
                                lf[n][e] = fmaxf(__builtin_amdgcn_logf(f), -100.0f);
                                v[n][e] = (1.0f - l) * fsigmoid(-z);
                            }
                        *(f32x4*)(LFp + off) = lf[0]; *(f32x4*)(LFp + off + 4) = lf[1];
                    } else if (typ == 3) {
#pragma unroll
                        for (int n = 0; n < 2; ++n)
#pragma unroll
                            for (int e = 0; e < 4; ++e) v[n][e] = fsilu(v[n][e]) * pa[bj][n][e];
                    }
                    *(v4u*)(slab + off) = cpk8(v[0], v[1]);
                }
            }
    }
};

struct EpiSW {
    static constexpr bool PERM = true, AFTER_DRAIN = false;
    const float* ssq; const float* gt;
    unsigned char* ws; float* out; int j;
    __device__ __forceinline__ void operator()(const f32x4 (&acc)[2][2][4][2], const Unit& u, int wr, int wc, int fr, int fq) const {
        const int row0 = u.pm * 256 + wr * 64 + fr, pn = u.pn;
        const int gi = pn < 3 ? 0 : pn - 2;
        f32x4 g[2][2];
#pragma unroll
        for (int bj = 0; bj < 2; ++bj)
#pragma unroll
            for (int n = 0; n < 2; ++n) g[bj][n] = *(const f32x4*)(gt + gi * 64 + 32 * bj + 8 * fq + 4 * n);
        bf16* const ob = (bf16*)(ws + (pn < 5 ? WS_P + (size_t)pn * 512 : WS_CQ)); const int opitch = pn < 5 ? 1280 : 256;
#pragma unroll
        for (int ai = 0; ai < 2; ++ai)
#pragma unroll
            for (int m = 0; m < 4; ++m) {
                const int row = row0 + ai * 128 + m * 16; const float r = rms_r(ssq, row);
                f32x4 v[2][2]; float ss = 0.f;
#pragma unroll
                for (int bj = 0; bj < 2; ++bj)
#pragma unroll
                    for (int n = 0; n < 2; ++n) { v[bj][n] = acc[ai][bj][m][n] * r; const f32x4 q = v[bj][n] * v[bj][n]; ss += (q[0] + q[1]) + (q[2] + q[3]); }
                ss += __shfl_xor(ss, 16); ss += __shfl_xor(ss, 32);
                const float rs = (pn == 4) ? 1.0f : __builtin_amdgcn_rsqf(ss * (1.0f / 64.0f) + EPS);
                long doff = -1;
                if (pn == 3 || pn == 4) {
                    if (row < MP) { const int t = row & 4095; if (t >= 3968) doff = (long)(pn == 3 ? O_SKP : O_SVP) + (long)j * (4 * 128 * 256) + ((long)((row >> 12) * 128 + (t - 3968)) * 4 + wc) * 64; }
                    else { const int idx = row - MP; doff = (long)(pn == 3 ? O_SKS : O_SVS) + (long)j * (128 * 128 * 256) + ((long)((idx >> 2) * 128 + 124 + (idx & 3)) * 4 + wc) * 64; }
                }
#pragma unroll
                for (int bj = 0; bj < 2; ++bj) {
                    const f32x4 o0 = v[bj][0] * rs * g[bj][0], o1 = v[bj][1] * rs * g[bj][1];
                    *(v4u*)(ob + (size_t)row * opitch + wc * 64 + 32 * bj + 8 * fq) = cpk8(o0, o1);
                    if (doff >= 0) { float* dst = out + doff + 32 * bj + 8 * fq; *(f32x4*)dst = o0; *(f32x4*)(dst + 4) = o1; }
                }
            }
    }
};

struct EpiMem {
    static constexpr bool PERM = true, AFTER_DRAIN = false;
    const float* ssq; const float* kn; bf16* MK; float* ok;
    __device__ __forceinline__ void operator()(const f32x4 (&acc)[2][2][4][2], const Unit& u, int wr, int wc, int fr, int fq) const {
        const int row0 = u.pm * 256 + wr * 64 + fr, layer = u.pn >> 1; const bool isv = (u.pn & 1) != 0;
        f32x4 g[2][2];
#pragma unroll
        for (int bj = 0; bj < 2; ++bj)
#pragma unroll
            for (int n = 0; n < 2; ++n) { const f32x4 gl = *(const f32x4*)(kn + layer * 64 + 32 * bj + 8 * fq + 4 * n); g[bj][n] = isv ? (f32x4){1.f, 1.f, 1.f, 1.f} : gl; }
#pragma unroll
        for (int ai = 0; ai < 2; ++ai)
#pragma unroll
            for (int m = 0; m < 4; ++m) {
                const int row = row0 + ai * 128 + m * 16; const float r = rms_r(ssq, row);
                f32x4 v[2][2]; float ss = 0.f;
#pragma unroll
                for (int bj = 0; bj < 2; ++bj)
#pragma unroll
                    for (int n = 0; n < 2; ++n) { v[bj][n] = acc[ai][bj][m][n] * r; const f32x4 q = v[bj][n] * v[bj][n]; ss += (q[0] + q[1]) + (q[2] + q[3]); }
                ss += __shfl_xor(ss, 16); ss += __shfl_xor(ss, 32);
                const float rs = isv ? 1.0f : __builtin_amdgcn_rsqf(ss * (1.0f / 64.0f) + EPS);
                const size_t off = (isv ? (size_t)1048576 : (size_t)0) + ((size_t)layer * 1024 + row) * 256 + wc * 64 + 8 * fq;
#pragma unroll
                for (int bj = 0; bj < 2; ++bj) {
                    const f32x4 o0 = v[bj][0] * rs * g[bj][0], o1 = v[bj][1] * rs * g[bj][1];
                    *(v4u*)(MK + off + 32 * bj) = cpk8(o0, o1);
                    float* dst = ok + off + 32 * bj;
                    *(f32x4*)dst = o0; *(f32x4*)(dst + 4) = o1;
                }
            }
    }
};

struct EpiFF1 {
    static constexpr bool PERM = true, AFTER_DRAIN = false;
    const float* ssq; bf16* ACT;
    __device__ __forceinline__ void operator()(const f32x4 (&acc)[2][2][4][2], const Unit& u, int wr, int wc, int fr, int fq) const {
        const int row0 = u.pm * 256 + wr * 64 + fr;
#pragma unroll
        for (int ai = 0; ai < 2; ++ai)
#pragma unroll
            for (int m = 0; m < 4; ++m) {
                const int row = row0 + ai * 128 + m * 16; const float r = rms_r(ssq, row);
                f32x4 a[2];
#pragma unroll
                for (int n = 0; n < 2; ++n)
#pragma unroll
                    for (int e = 0; e < 4; ++e) a[n][e] = fsilu(acc[ai][0][m][n][e] * r) * (acc[ai][1][m][n][e] * r);
                *(v4u*)(ACT + (size_t)row * DFF + u.pn * 128 + wc * 32 + 8 * fq) = cpk8(a[0], a[1]);
            }
    }
};

struct EpiRes {
    static constexpr bool PERM = true, AFTER_DRAIN = false;
    const float* base_p; long sdelta; float* out; bf16* XB; float* ssq_out;
    __device__ __forceinline__ void operator()(const f32x4 (&acc)[2][2][4][2], const Unit& u, int wr, int wc, int fr, int fq) const {
        const int row0 = u.pm * 256 + wr * 64 + fr, col0 = u.pn * 256 + wc * 32 + 8 * fq;
        const float* base = base_p + ((u.pm < 64) ? 0L : sdelta);
#pragma unroll
        for (int ai = 0; ai < 2; ++ai)
#pragma unroll
            for (int m = 0; m < 4; ++m) {
                const int row = row0 + ai * 128 + m * 16; float s = 0.f;
#pragma unroll
                for (int bj = 0; bj < 2; ++bj) {
                    const size_t off = (size_t)row * D + col0 + bj * 128;
                    const f32x4 x0 = *(const f32x4*)(base + off) + acc[ai][bj][m][0], x1 = *(const f32x4*)(base + off + 4) + acc[ai][bj][m][1];
                    *(f32x4*)(out + off) = x0; *(f32x4*)(out + off + 4) = x1;
                    if (XB) {
                        *(v4u*)(XB + off) = cpk8(x0, x1);
                        const f32x4 q0 = x0 * x0, q1 = x1 * x1; s += ((q0[0] + q0[1]) + (q0[2] + q0[3])) + ((q1[0] + q1[1]) + (q1[2] + q1[3]));
                    }
                }
                if (XB) {
                    s += __shfl_xor(s, 16); s += __shfl_xor(s, 32);
                    if (fq == 0) (void)__hip_atomic_fetch_add(ssq_out + row, s, __ATOMIC_RELAXED, __HIP_MEMORY_SCOPE_AGENT);
                }
            }
    }
};

__device__ __forceinline__ void tr_item(const float* W, int K, int N, const float* gain, bf16* WT, int dst_row0, int k0, int n0, LAS float* scr, int lane) {
#pragma unroll 8
    for (int i = 0; i < 32; ++i) { const int kk = 2 * i + (lane >> 5); const float gk = gain ? gain[k0 + kk] : 1.0f; scr[kk * 33 + (lane & 31)] = W[(size_t)(k0 + kk) * N + n0 + (lane & 31)] * gk; }
    LDS_WAIT(); asm volatile("" ::: "memory");
    const int c = lane & 7;
#pragma unroll
    for (int j = 0; j < 4; ++j) { const int n = (lane >> 3) + 8 * j; const LAS float* s = scr + (8 * c) * 33 + n;
        v4u o; o.x = cpk(s[0 * 33], s[1 * 33]); o.y = cpk(s[2 * 33], s[3 * 33]); o.z = cpk(s[4 * 33], s[5 * 33]); o.w = cpk(s[6 * 33], s[7 * 33]);
        *(v4u*)(WT + (size_t)(dst_row0 + n) * K + k0 + 8 * c) = o; }
    LDS_WAIT(); asm volatile("" ::: "memory");
}
__device__ __forceinline__ int head_row0(int n0) { return (n0 & ~255) + 128 * ((n0 >> 5) & 1) + 32 * ((n0 >> 6) & 3); }
__device__ __forceinline__ float row_to_bf16(const float* xrow, bf16* orow, int lane) {
    const f32x4* xr = (const f32x4*)xrow + lane; float s = 0.f;
    unsigned long long* o8 = (unsigned long long*)orow + lane;
#pragma unroll
    for (int j = 0; j < 4; ++j) { const f32x4 v = xr[64 * j]; s += (v[0] * v[0] + v[1] * v[1]) + (v[2] * v[2] + v[3] * v[3]);
        o8[64 * j] = (unsigned long long)cpk(v[0], v[1]) | ((unsigned long long)cpk(v[2], v[3]) << 32); }
    return wave_sum(s);
}


#define LAUNDER_S(x) asm volatile("" : "+s"(x))
#define INP(k) ({ int k_ = (k); LAUNDER_S(k_); (const float*)(const GAS float*)a.in[k_]; })
struct Args { const float* in[24]; float* out; unsigned char* ws; int ph_lo, ph_hi, use_bar, pad; };

struct Ctx {
    ldsp lds; int tid, lane, wid, G, bid;
    const float* const* in; float* out; unsigned char* ws;
};

__device__ __forceinline__ void phase_prologue(const Args& a, ldsp lds, int tid, int lane, int wid, int bid, int G) {
    GAS unsigned char* wsg_ = (GAS unsigned char*)a.ws; LAUNDER_S(wsg_); unsigned char* ws = (unsigned char*)wsg_;
    LAS float* scr = (LAS float*)(lds + wid * 16384);
    const int gw = bid * NWAVES + wid, NGW = G * NWAVES;
    constexpr int I_WH = 16 * 104, I_WS = 16 * 48, I_WM = 16 * 16, I_WO = 16 * 32, I_F1 = 16 * 176, I_F2 = 44 * 32;
    constexpr int N_WH = 2 * I_WH, N_WS = 2 * I_WS, N_WM = 4 * I_WM, N_WO = 4 * I_WO, N_F1 = 4 * I_F1, N_F2 = 4 * I_F2;
    constexpr int NITEMS = N_WH + N_WS + N_WM + N_WO + N_F1 + N_F2;
    for (int it = gw; it < NITEMS; it += NGW) {
        int r = it;
        if (r < N_WH) { const int j = r / I_WH, q = r % I_WH, kb = q / 104, nb = q % 104, n0 = nb * 32;
            tr_item(INP(11) + (size_t)j * D * HG_IN, D, HG_IN, INP(8) + (2 * j) * D, (bf16*)(ws + WS_WINH) + (size_t)j * HG_IN * D, n0 < 3072 ? n0 : head_row0(n0), kb * 64, n0, scr, lane); continue; } r -= N_WH;
        if (r < N_WS) { const int j = r / I_WS, q = r % I_WS, kb = q / 48, nb = q % 48, n0 = nb * 32;
            tr_item(INP(14) + (size_t)j * D * SW_IN, D, SW_IN, INP(8) + (2 * j + 1) * D, (bf16*)(ws + WS_WINS) + (size_t)j * SW_IN * D, head_row0(n0), kb * 64, n0, scr, lane); continue; } r -= N_WS;
        if (r < N_WM) { const int i = r / I_WM, q = r % I_WM, kb = q / 16, nb = q % 16, n0 = nb * 32;
            tr_item(INP(18) + (size_t)i * D * 512, D, 512, INP(10) + i * D, (bf16*)(ws + WS_WMEM), 512 * i + head_row0(n0), kb * 64, n0, scr, lane); continue; } r -= N_WM;
        if (r < N_WO) { const int i = r / I_WO, q = r % I_WO, kb = q / 32, nb = q % 32, n0 = nb * 32;
            tr_item(INP(21) + (size_t)i * D * D, D, D, nullptr, (bf16*)(ws + WS_WOUT) + (size_t)i * D * D, n0, kb * 64, n0, scr, lane); continue; } r -= N_WO;
        if (r < N_F1) { const int i = r / I_F1, q = r % I_F1, kb = q / 176, nb = q % 176, n0 = nb * 32; const int jj = n0 < DFF ? n0 : n0 - DFF;
            tr_item(INP(22) + (size_t)i * D * NFF1, D, NFF1, INP(9) + i * D, (bf16*)(ws + WS_WFF1) + (size_t)i * NFF1 * D, 256 * (jj >> 7) + (n0 < DFF ? 0 : 128) + (jj & 127), kb * 64, n0, scr, lane); continue; } r -= N_F1;
        { const int i = r / I_F2, q = r % I_F2, kb = q / 32, nb = q % 32, n0 = nb * 32;
            tr_item(INP(23) + (size_t)i * DFF * D, DFF, D, nullptr, (bf16*)(ws + WS_WFF2) + (size_t)i * D * DFF, n0, kb * 64, n0, scr, lane); }
    }
    float* ssq0 = (float*)(ws + WS_CTL) + CW_SSQ;
    for (int m = gw; m < M; m += NGW) {
        const float* xr = m < MP ? INP(0) + (size_t)m * D : INP(1) + (size_t)(m - MP) * D;
        const float s = row_to_bf16(xr, (bf16*)(ws + WS_XB) + (size_t)m * D, lane);
        if (lane == 0) ssq0[m] = s;
    }
    float* ssqm = (float*)(ws + WS_SMALL + 16384);
    for (int m = gw; m < 1024; m += NGW) {
        const float s = row_to_bf16(INP(7) + (size_t)m * D, (bf16*)(ws + WS_MEMB) + (size_t)m * D, lane);
        if (lane == 0) ssqm[m] = s;
    }
    if (bid == 0) {
        float* pt = (float*)(ws + WS_SMALL);
        for (int c = tid; c < TOKW; c += NTHR) {
            const float r0 = INP(12)[c], r1 = INP(12)[TOKW + c], mx = fmaxf(r0, r1), e0 = __expf(r0 - mx), e1 = __expf(r1 - mx), sm1 = e1 / (e0 + e1);
            pt[c] = 0.0f; pt[2048 + c] = fminf(fmaxf(sm1, 0.0f), 0.999f);
            pt[768 + c] = INP(13)[c]; pt[2048 + 768 + c] = INP(13)[TOKW + c];
        }
        if (tid < 64) { pt[1536 + tid] = INP(19)[tid]; pt[2048 + 1536 + tid] = INP(19)[128 + tid]; }
        float* gt = (float*)(ws + WS_SMALL + 32768);
        if (tid < 128) { const int j = tid >> 6, d = tid & 63; gt[j * 256 + d] = INP(15)[j * 64 + d]; gt[j * 256 + 64 + d] = INP(16)[j * 64 + d]; gt[j * 256 + 128 + d] = 1.0f; gt[j * 256 + 192 + d] = INP(19)[(2 * j + 1) * 64 + d]; }
    }
}

constexpr int KSTR = 144;
__device__ __forceinline__ void stage_bf16_rows(ldsp dst, const bf16* src, long pitch, int row_lo, int nrows, int tid) {
    for (int idx = tid; idx < nrows * 8; idx += NTHR) {
        const int row = idx >> 3, ch = idx & 7; v4u v = {0u, 0u, 0u, 0u};
        if (row_lo + row >= 0) v = *(const v4u*)(src + (long)(row_lo + row) * pitch + ch * 8);
        *(LAS v4u*)(dst + row * KSTR + ch * 16) = v;
    }
}
__device__ __forceinline__ void stage_f32_rows(ldsp dst, const float* src, long pitch, int nrows, int tid, float* cpy, long cpitch, int copy_lo) {
    for (int idx = tid; idx < nrows * 8; idx += NTHR) {
        const int row = idx >> 3, ch = idx & 7;
        const f32x4 a = *(const f32x4*)(src + (long)row * pitch + ch * 8), b = *(const f32x4*)(src + (long)row * pitch + ch * 8 + 4);
        *(LAS v4u*)(dst + row * KSTR + ch * 16) = cpk8(a, b);
        if (cpy && row >= copy_lo) { float* c = cpy + (long)(row - copy_lo) * cpitch + ch * 8; *(f32x4*)c = a; *(f32x4*)(c + 4) = b; }
    }
}
struct AttnP { unsigned char* ws; const bf16* MK; const float* cmk; const float* cmv; const float* csk; const float* csv; const float* sinks; float* oks; };
__device__ __forceinline__ void attn_phase(int u_lo, const AttnP& P, ldsp lds, int tid, int lane, int wid, int bid, int G) {
    const int r = lane & 31, h = lane >> 5, i16 = lane & 15, g4 = lane >> 4;
    const int vlane = (4 * h + (i16 >> 2)) * KSTR + (16 * (g4 & 1) + 4 * (i16 & 3)) * 2;
    const bf16* const QKVp = (const bf16*)(P.ws + WS_P); bf16* const ATTp = (bf16*)(P.ws + WS_ATT);
#pragma unroll 1
    for (int uu = u_lo + bid; uu < 1536; uu += G) {
        const int typ = uu < 256 ? 0 : uu < 768 ? 1 : uu < 1024 ? 2 : 3;
        ldsp Ks = lds; ldsp Vs = lds + 384 * KSTR;
        int nitems = 0;
        if (typ == 0) {
            const int u = uu, b = u >> 6, kvh = (u >> 4) & 3, qblk = u & 15;
            const bf16* kbase = QKVp + (size_t)b * SEQ * 1280 + 768 + kvh * 64;
            stage_bf16_rows(Ks, kbase, 1280, 256 * qblk - 128, 384, tid);
            stage_bf16_rows(Vs, kbase + 256, 1280, 256 * qblk - 128, 384, tid);
            nitems = 3;
        } else if (typ == 1) {
            const int u = uu - 256, b = u >> 2, kvh = u & 3;
            stage_f32_rows(Ks, P.csk + (size_t)b * 128 * 256 + kvh * 64, 256, 128, tid, P.oks + (size_t)b * 128 * 256 + kvh * 64, 256, 4);
            stage_f32_rows(Vs, P.csv + (size_t)b * 128 * 256 + kvh * 64, 256, 128, tid, P.oks + (O_SVS - O_SKS) + (size_t)b * 128 * 256 + kvh * 64, 256, 4);
            if (tid < 256) {
                const int which = tid >> 7, idx = tid & 127, row = 128 + (idx >> 2), ch2 = idx & 3;
                v4u v0 = {0u, 0u, 0u, 0u}, v1 = {0u, 0u, 0u, 0u};
                if (row < 132) { const bf16* src = QKVp + ((size_t)MP + 4 * b + (row - 128)) * 1280 + 768 + which * 256 + kvh * 64 + ch2 * 16; v0 = *(const v4u*)src; v1 = *(const v4u*)(src + 8); }
                ldsp d = lds + (which ? 384 * KSTR : 0) + row * KSTR + ch2 * 32;
                *(LAS v4u*)d = v0; *(LAS v4u*)(d + 16) = v1;
            }
            nitems = wid == 0 ? 1 : 0;
        } else if (typ == 2) {
            const int u = uu - 768, b = u >> 6, hd = (u >> 4) & 3;
            stage_bf16_rows(Ks, P.MK + (size_t)b * 256 * 256 + hd * 64, 256, 0, 256, tid);
            stage_bf16_rows(Vs, P.MK + 1048576 + (size_t)b * 256 * 256 + hd * 64, 256, 0, 256, tid);
            nitems = 1;
        } else {
            const int u = uu - 1024, b = u >> 2, hd = u & 3;
            stage_f32_rows(Ks, P.cmk + (size_t)b * 256 * 256 + hd * 64, 256, 256, tid, nullptr, 0, 0);
            stage_f32_rows(Vs, P.cmv + (size_t)b * 256 * 256 + hd * 64, 256, 256, tid, nullptr, 0, 0);
            nitems = wid == 0 ? 1 : 0;
        }
        __syncthreads();
#pragma unroll 1
        for (int it = 0; it < nitems; ++it) {
            size_t qoff, doff; int nkb, krow0, klo, khi; float sink2; bool valid;
            if (typ == 0) {
                const int u = uu, b = u >> 6, kvh = (u >> 4) & 3, qblk = u & 15, item = wid + 8 * it, gq = item >> 3, qsub = item & 7, head = kvh * 3 + gq, q0 = 256 * qblk + 32 * qsub;
                const size_t qrow = (size_t)b * SEQ + q0 + r;
                qoff = qrow * 1280 + head * 64; doff = qrow * D + head * 64; nkb = 5; krow0 = 32 * qsub;
                klo = max(r + 1, 128 - q0); khi = r + 128; sink2 = P.sinks[head] * LOG2E; valid = true;
            } else if (typ == 1) {
                const int u = uu - 256, b = u >> 2, kvh = u & 3, rr = r < 12 ? r : 0, gq = rr >> 2, t = rr & 3, head = kvh * 3 + gq;
                const size_t qrow = (size_t)MP + 4 * b + t;
                qoff = qrow * 1280 + head * 64; doff = qrow * D + head * 64; nkb = 5; krow0 = 0;
                klo = t + 1; khi = t + 128; sink2 = P.sinks[head] * LOG2E; valid = r < 12;
            } else if (typ == 2) {
                const int u = uu - 768, b = u >> 6, hd = (u >> 4) & 3, qblk = u & 15;
                const size_t qrow = (size_t)b * SEQ + 256 * qblk + 32 * wid + r;
                qoff = qrow * 256 + hd * 64; doff = qrow * D + TOKW + hd * 64; nkb = 8; krow0 = 0; klo = 0; khi = 1 << 20; sink2 = -1e30f; valid = true;
            } else {
                const int u = uu - 1024, b = u >> 2, hd = u & 3;
                const size_t qrow = (size_t)MP + 4 * b + (r & 3);
                qoff = qrow * 256 + hd * 64; doff = qrow * D + TOKW + hd * 64; nkb = 8; krow0 = 0; klo = 0; khi = 1 << 20; sink2 = -1e30f; valid = r < 4;
            }
            const bf16* qsrc = (const bf16*)(P.ws + ((typ == 0 || typ == 1) ? WS_P : WS_CQ));
            bf16x8 qf[4];
#pragma unroll
            for (int d0 = 0; d0 < 4; ++d0) qf[d0] = *(const bf16x8*)(qsrc + qoff + d0 * 16 + h * 8);
            LAS const unsigned char* Kb = Ks + krow0 * KSTR; LAS const unsigned char* Vb = Vs + krow0 * KSTR;
            const float sc = 0.125f * LOG2E;
            float mx = -1e30f;
#pragma unroll 1
            for (int kb = 0; kb < nkb; ++kb) {
                f32x16 s;
#pragma unroll
                for (int e = 0; e < 16; ++e) s[e] = 0.f;
#pragma unroll
                for (int d0 = 0; d0 < 4; ++d0) { const bf16x8 kf = *(LAS const bf16x8*)(Kb + (kb * 32 + r) * KSTR + d0 * 32 + h * 16); s = MFMA32(kf, qf[d0], s); }
#pragma unroll
                for (int e = 0; e < 16; ++e) { const int kidx = kb * 32 + (e & 3) + 8 * (e >> 2) + 4 * h; const bool ok = kidx >= klo && kidx <= khi; mx = fmaxf(mx, ok ? s[e] * sc : -1e30f); }
            }
            mx = fmaxf(mx, __shfl_xor(mx, 32));
            const float mfin = fmaxf(mx, sink2);
            float lsum = 0.f; f32x16 o[2];
#pragma unroll
            for (int e = 0; e < 16; ++e) { o[0][e] = 0.f; o[1][e] = 0.f; }
#pragma unroll 1
            for (int kb = 0; kb < nkb; ++kb) {
                f32x16 s;
#pragma unroll
                for (int e = 0; e < 16; ++e) s[e] = 0.f;
#pragma unroll
                for (int d0 = 0; d0 < 4; ++d0) { const bf16x8 kf = *(LAS const bf16x8*)(Kb + (kb * 32 + r) * KSTR + d0 * 32 + h * 16); s = MFMA32(kf, qf[d0], s); }
#pragma unroll
                for (int e = 0; e < 16; ++e) { const int kidx = kb * 32 + (e & 3) + 8 * (e >> 2) + 4 * h; const bool ok = kidx >= klo && kidx <= khi; const float pv = ok ? fexp2(s[e] * sc - mfin) : 0.f; s[e] = pv; lsum += pv; }
#pragma unroll
                for (int ks = 0; ks < 2; ++ks) {
                    v4u pw; pw.x = cpk(s[8 * ks + 0], s[8 * ks + 1]); pw.y = cpk(s[8 * ks + 2], s[8 * ks + 3]); pw.z = cpk(s[8 * ks + 4], s[8 * ks + 5]); pw.w = cpk(s[8 * ks + 6], s[8 * ks + 7]);
                    const bf16x8 pb = __builtin_bit_cast(bf16x8, pw);
#pragma unroll
                    for (int d0 = 0; d0 < 2; ++d0) {
                        LAS const unsigned char* vp = Vb + (kb * 32 + 16 * ks) * KSTR + d0 * 64 + vlane;
                        const bf16x8 va = cat8(ldtr(vp), ldtr(vp + 8 * KSTR));
                        o[d0] = MFMA32(va, pb, o[d0]);
                    }
                }
            }
            const float ltot = lsum + __shfl_xor(lsum, 32) + fexp2(sink2 - mfin);
            const float linv = 1.0f / ltot;
            if (valid) {
                bf16* dst = ATTp + doff;
#pragma unroll
                for (int d0 = 0; d0 < 2; ++d0)
#pragma unroll
                    for (int rg = 0; rg < 4; ++rg)
                        *(unsigned long long*)(dst + d0 * 32 + 8 * rg + 4 * h) = (unsigned long long)cpk(o[d0][4 * rg] * linv, o[d0][4 * rg + 1] * linv) | ((unsigned long long)cpk(o[d0][4 * rg + 2] * linv, o[d0][4 * rg + 3] * linv) << 32);
            }
        }
        __syncthreads();
    }
}

__device__ __forceinline__ void hg_sample_unit(int u, ldsp lds, const bf16* QF, const bf16* KF, const bf16* VI, const bf16* OG, const float* LF, const float* S0, float* Sout, bf16* ATT, int tid) {
    const int b = u / 6, hh = u % 6, v = tid & 127, kg = tid >> 7;
    LAS float* vq = (LAS float*)lds;
    LAS float* vf = vq + 512;
    LAS float* vk = vf + 512;
    LAS float* po = vk + 512;
    LAS float* red = po + 512;
    {
        const size_t off = ((size_t)MP + 4 * b + kg) * 768 + hh * 128 + v;
        vq[tid] = bf2f(QF[off]); vf[tid] = fexp2(LF[off]); vk[tid] = bf2f(KF[off]);
    }
    float S[32];
    const float* s0 = S0 + ((size_t)b * 6 + hh) * 16384 + (size_t)(kg * 32) * 128 + v;
#pragma unroll
    for (int i = 0; i < 32; ++i) S[i] = s0[(size_t)i * 128];
    __syncthreads();
#pragma unroll 1
    for (int t = 0; t < 4; ++t) {
        const size_t row = (size_t)MP + 4 * b + t;
        const float vv = bf2f(VI[row * 768 + hh * 128 + v]);
        float po_ = 0.f;
#pragma unroll
        for (int i = 0; i < 32; ++i) { const int k = kg * 32 + i; S[i] = vf[t * 128 + k] * S[i] + vk[t * 128 + k] * vv; po_ += S[i] * vq[t * 128 + k]; }
        po[kg * 128 + v] = po_;
        __syncthreads();
        const float ov = (po[v] + po[128 + v]) + (po[256 + v] + po[384 + v]);
        float sq = wave_sum(ov * ov);
        if ((tid & 63) == 0) red[tid >> 6] = sq;
        __syncthreads();
        const float tot = red[0] + red[1];
        const float rs = __builtin_amdgcn_rsqf(tot * (1.0f / 128.0f) + EPS);
        if (kg == 0) { const float og = bf2f(OG[row * 768 + hh * 128 + v]); ATT[row * D + hh * 128 + v] = (bf16)(cpk(ov * rs * og, 0.f) & 0xffffu); }
        __syncthreads();
    }
    float* so = Sout + ((size_t)b * 6 + hh) * 16384 + (size_t)(kg * 32) * 128 + v;
#pragma unroll
    for (int i = 0; i < 32; ++i) so[(size_t)i * 128] = S[i];
}

constexpr int QSTR = 272, ASTR = 144, KTSTR = 144;
struct HgFront { float loc[16]; float kfv[16]; float bI; float tj[4]; };
__device__ __forceinline__ void hg_front(HgFront& F, const bf16* KF, const float* LF, size_t m0, int col0, LAS float* tot, int tid) {
    const int c = tid & 127, I = tid >> 7;
    float run = 0.f;
#pragma unroll
    for (int i = 0; i < 16; ++i) { const size_t off = (m0 + 16 * I + i) * 768 + col0 + c; run += LF[off]; F.loc[i] = run; F.kfv[i] = bf2f(KF[off]); }
    tot[I * 128 + c] = run;
    __syncthreads();
#pragma unroll
    for (int j = 0; j < 4; ++j) F.tj[j] = tot[j * 128 + c];
    F.bI = 0.f;
#pragma unroll
    for (int j = 0; j < 3; ++j) if (j < I) F.bI += F.tj[j];
}
__device__ __forceinline__ void hg_stage_v(ldsp Vs, const bf16* VI, size_t m0, int col0, int tid) {
    for (int idx = tid; idx < 1024; idx += NTHR) { const int row = idx >> 4, ch = idx & 15; *(LAS v4u*)(Vs + row * QSTR + ch * 16) = *(const v4u*)(VI + (m0 + row) * 768 + col0 + ch * 8); }
}
__device__ __forceinline__ bf16x8 hg_vt_frag(ldsp Vs, int vb, int ks, int lane) {
    const int h = lane >> 5, i16 = lane & 15, g = lane >> 4;
    LAS const unsigned char* p = Vs + (16 * ks + 8 * h + (i16 >> 2)) * QSTR + (vb * 32 + 16 * (g & 1) + 4 * (i16 & 3)) * 2;
    return cat8(ldtr(p), ldtr(p + 4 * QSTR));
}
__device__ __forceinline__ void hg_h1_unit(int unit, ldsp lds, const bf16* KF, const bf16* VI, const float* LF, float* U, float* DD, int tid, int lane, int wid) {
    const int n = unit & 63, bh = unit >> 6, b = bh / 6, hh = bh % 6, col0 = hh * 128;
    const size_t m0 = (size_t)b * SEQ + 64 * n;
    ldsp KT = lds, Vs = lds + 128 * KTSTR; LAS float* tot = (LAS float*)(lds + 128 * KTSTR + 64 * QSTR);
    HgFront F; hg_front(F, KF, LF, m0, col0, tot, tid);
    const int c = tid & 127, I = tid >> 7;
    const float total = (F.tj[0] + F.tj[1]) + (F.tj[2] + F.tj[3]);
    {
        float kt[16];
#pragma unroll
        for (int i = 0; i < 16; ++i) kt[i] = F.kfv[i] * fexp2(total - F.bI - F.loc[i]);
        v4u w0, w1;
        w0.x = cpk(kt[0], kt[1]); w0.y = cpk(kt[2], kt[3]); w0.z = cpk(kt[4], kt[5]); w0.w = cpk(kt[6], kt[7]);
        w1.x = cpk(kt[8], kt[9]); w1.y = cpk(kt[10], kt[11]); w1.z = cpk(kt[12], kt[13]); w1.w = cpk(kt[14], kt[15]);
        *(LAS v4u*)(KT + c * KTSTR + 32 * I) = w0; *(LAS v4u*)(KT + c * KTSTR + 32 * I + 16) = w1;
    }
    hg_stage_v(Vs, VI, m0, col0, tid);
    if (I == 0) DD[(size_t)unit * 128 + c] = fexp2(total);
    __syncthreads();
    const int r = lane & 31, h = lane >> 5, vb = wid >> 1, cb0 = 2 * (wid & 1);
    f32x16 acc[2];
#pragma unroll
    for (int e = 0; e < 16; ++e) { acc[0][e] = 0.f; acc[1][e] = 0.f; }
#pragma unroll
    for (int ks = 0; ks < 4; ++ks) {
        const bf16x8 va = hg_vt_frag(Vs, vb, ks, lane);
#pragma unroll
        for (int cc = 0; cc < 2; ++cc) { const bf16x8 kb = *(LAS const bf16x8*)(KT + ((cb0 + cc) * 32 + r) * KTSTR + (16 * ks + 8 * h) * 2); acc[cc] = MFMA32(va, kb, acc[cc]); }
    }
    float* Uu = U + (size_t)unit * 16384;
#pragma unroll
    for (int cc = 0; cc < 2; ++cc)
#pragma unroll
        for (int e = 0; e < 16; ++e) Uu[(size_t)(vb * 32 + (e & 3) + 8 * (e >> 2) + 4 * h) * 128 + (cb0 + cc) * 32 + r] = acc[cc][e];
    __syncthreads();
}
__device__ __forceinline__ void hg_h2(const float* U, const float* DD, bf16* ST, float* fin, int gtid) {
    if (gtid >= 24 * 4096) return;
    const int bh = gtid >> 12, e4 = gtid & 4095, v = e4 >> 5, c4 = (e4 & 31) * 4;
    f32x4 S = {0.f, 0.f, 0.f, 0.f};
#pragma unroll 1
    for (int n0 = 0; n0 < 64; n0 += 8) {
        f32x4 uu[8], dd[8];
#pragma unroll
        for (int k = 0; k < 8; ++k) { const size_t unit = (size_t)bh * 64 + n0 + k; uu[k] = *(const f32x4*)(U + (unit * 128 + v) * 128 + c4); dd[k] = *(const f32x4*)(DD + unit * 128 + c4); }
#pragma unroll
        for (int k = 0; k < 8; ++k) { const size_t unit = (size_t)bh * 64 + n0 + k;
            *(unsigned long long*)(ST + (unit * 128 + v) * 128 + c4) = (unsigned long long)cpk(S[0], S[1]) | ((unsigned long long)cpk(S[2], S[3]) << 32);
            S = dd[k] * S + uu[k]; }
    }
    float* f = fin + (size_t)bh * 16384 + v;
#pragma unroll
    for (int e = 0; e < 4; ++e) f[(size_t)(c4 + e) * 128] = S[e];
}
__device__ __forceinline__ void hg_h3_unit(int unit, ldsp lds, const bf16* QF, const bf16* KF, const bf16* VI, const bf16* OG, const float* LF, const bf16* ST, bf16* ATT, int tid, int lane, int wid) {
    const int n = unit & 63, bh = unit >> 6, b = bh / 6, hh = bh % 6, col0 = hh * 128;
    const size_t m0 = (size_t)b * SEQ + 64 * n;
    ldsp QI = lds, Q0 = QI + 64 * QSTR, KX = Q0 + 64 * QSTR, Vs = KX + 160 * QSTR, AT = Vs + 64 * QSTR;
    LAS float* tot = (LAS float*)(AT + 64 * ASTR); LAS float* red = tot + 512;
    {
        for (int idx = tid; idx < 64 * ASTR / 16; idx += NTHR) *(LAS v4u*)(AT + idx * 16) = (v4u){0u, 0u, 0u, 0u};
    }
    HgFront F; hg_front(F, KF, LF, m0, col0, tot, tid);
    const int c = tid & 127, I = tid >> 7;
    {
        float bJ[4]; bJ[0] = 0.f; bJ[1] = F.tj[0]; bJ[2] = F.tj[0] + F.tj[1]; bJ[3] = (F.tj[0] + F.tj[1]) + F.tj[2];
#pragma unroll
        for (int i = 0; i < 16; ++i) {
            const int t = 16 * I + i;
            const float qv = bf2f(QF[(m0 + t) * 768 + col0 + c]);
            const float qi = qv * fexp2(F.loc[i]);
            *(LAS bf16*)(QI + t * QSTR + c * 2) = (bf16)(cpk(qi, 0.f) & 0xffffu);
            *(LAS bf16*)(Q0 + t * QSTR + c * 2) = (bf16)(cpk(qi * fexp2(F.bI), 0.f) & 0xffffu);
#pragma unroll
            for (int Ip = 0; Ip < 4; ++Ip)
                if (Ip >= I) { const float e = fminf((bJ[Ip] - F.bI) - F.loc[i], 80.0f);
                    *(LAS bf16*)(KX + (8 * Ip * (Ip + 1) + t) * QSTR + c * 2) = (bf16)(cpk(F.kfv[i] * fexp2(e), 0.f) & 0xffffu); }
        }
    }
    hg_stage_v(Vs, VI, m0, col0, tid);
    __syncthreads();
    {
        const int r16 = lane & 15, kq = lane >> 4;
        for (int p = wid; p < 10; p += 8) {
            const int Ip = p < 1 ? 0 : p < 3 ? 1 : p < 6 ? 2 : 3, J = p - (Ip * (Ip + 1)) / 2;
            f32x4 a4 = {0.f, 0.f, 0.f, 0.f};
#pragma unroll
            for (int kst = 0; kst < 4; ++kst) {
                const bf16x8 af = *(LAS const bf16x8*)(KX + (8 * Ip * (Ip + 1) + 16 * J + r16) * QSTR + (32 * kst + 8 * kq) * 2);
                const bf16x8 bf = *(LAS const bf16x8*)(QI + (16 * Ip + r16) * QSTR + (32 * kst + 8 * kq) * 2);
                a4 = MFMA16(af, bf, a4);
            }
            const int t = 16 * Ip + r16, s0 = 16 * J + 4 * kq;
            float w[4];
#pragma unroll
            for (int e = 0; e < 4; ++e) w[e] = (s0 + e <= t) ? a4[e] : 0.f;
            *(LAS unsigned long long*)(AT + t * ASTR + s0 * 2) = (unsigned long long)cpk(w[0], w[1]) | ((unsigned long long)cpk(w[2], w[3]) << 32);
        }
    }
    __syncthreads();
    const int r = lane & 31, h = lane >> 5, vb = wid >> 1, tb = wid & 1;
    f32x16 acc;
#pragma unroll
    for (int e = 0; e < 16; ++e) acc[e] = 0.f;
#pragma unroll
    for (int ks = 0; ks < 4; ++ks) {
        const bf16x8 va = hg_vt_frag(Vs, vb, ks, lane);
        const bf16x8 ab = *(LAS const bf16x8*)(AT + (tb * 32 + r) * ASTR + (16 * ks + 8 * h) * 2);
        acc = MFMA32(va, ab, acc);
    }
    const bf16* Su = ST + ((size_t)unit * 128 + vb * 32 + r) * 128;
#pragma unroll
    for (int ks = 0; ks < 8; ++ks) {
        const bf16x8 sa = *(const bf16x8*)(Su + 16 * ks + 8 * h);
        const bf16x8 qb = *(LAS const bf16x8*)(Q0 + (tb * 32 + r) * QSTR + (16 * ks + 8 * h) * 2);
        acc = MFMA32(sa, qb, acc);
    }
    float ss = 0.f;
#pragma unroll
    for (int e = 0; e < 16; ++e) ss += acc[e] * acc[e];
    ss += __shfl_xor(ss, 32);
    if (h == 0) red[vb * 64 + tb * 32 + r] = ss;
    __syncthreads();
    const int t = tb * 32 + r;
    const float tot2 = (red[t] + red[64 + t]) + (red[128 + t] + red[192 + t]);
    const float rs = __builtin_amdgcn_rsqf(tot2 * (1.0f / 128.0f) + EPS);
    const size_t row = m0 + t;
#pragma unroll
    for (int rg = 0; rg < 4; ++rg) {
        const int v0 = vb * 32 + 8 * rg + 4 * h;
        const unsigned long long gw = *(const unsigned long long*)(OG + row * 768 + col0 + v0);
        const float g0 = bf2f((unsigned short)gw), g1 = bf2f((unsigned short)(gw >> 16)), g2 = bf2f((unsigned short)(gw >> 32)), g3 = bf2f((unsigned short)(gw >> 48));
        *(unsigned long long*)(ATT + row * D + col0 + v0) = (unsigned long long)cpk(acc[4 * rg] * rs * g0, acc[4 * rg + 1] * rs * g1) | ((unsigned long long)cpk(acc[4 * rg + 2] * rs * g2, acc[4 * rg + 3] * rs * g3) << 32);
    }
    __syncthreads();
}

#ifndef MK_PER_PHASE
#define MK_PER_PHASE 1
#endif
constexpr int N_PHASES = 25;
enum Kind { K_PRO = 0, K_G1H, K_MIX, K_H2, K_H3, K_G1S, K_G2, K_G3, K_G4 };

__global__ void __launch_bounds__(NTHR, 2) fwd_kernel(Args a) {
    extern __shared__ __attribute__((aligned(16))) unsigned char lds_raw[];
    ldsp lds = (ldsp)lds_raw;
    const int tid0 = threadIdx.x, bid = blockIdx.x, G = gridDim.x;
    volatile LAS unsigned* MISC = (volatile LAS unsigned*)(lds + MISC_OFF);
    for (int u = tid0; u < (LDS_BYTES - RING_BYTES) / 4; u += NTHR) ((LAS unsigned*)(lds + RING_BYTES))[u] = 0u;
    __syncthreads();
    XcdBarrier bar; bar.bar = (unsigned*)(a.ws + WS_CTL) + CW_BAR; bar.x = 0; bar.st = nullptr;
    if (a.use_bar) bar = xcd_barrier_post((unsigned*)(a.ws + WS_CTL) + CW_BAR, MISC + 8);

#pragma unroll 1
    for (int p = a.ph_lo; p < a.ph_hi; ++p) {
        int l = 0, st = 0, kind = K_PRO;
        if (p > 0) {
            const int q = p - 1;
            if (q < 7) { l = 0; st = q; } else if (q < 12) { l = 1; st = q - 7; } else if (q < 19) { l = 2; st = q - 12; } else { l = 3; st = q - 19; }
            if ((l & 1) == 0) kind = st == 0 ? K_G1H : st == 1 ? K_MIX : st == 2 ? K_H2 : st == 3 ? K_H3 : st == 4 ? K_G2 : st == 5 ? K_G3 : K_G4;
            else kind = st == 0 ? K_G1S : st == 1 ? K_MIX : st == 2 ? K_G2 : st == 3 ? K_G3 : K_G4;
        }
        const int j = l >> 1;
        int tid = threadIdx.x; asm volatile("" : "+v"(tid));
        const int lane = tid & 63, wid = __builtin_amdgcn_readfirstlane(tid >> 6);
        GAS unsigned char* wsg_ = (GAS unsigned char*)a.ws; LAUNDER_S(wsg_); unsigned char* ws = (unsigned char*)wsg_;
        GAS float* outg_ = (GAS float*)a.out; LAUNDER_S(outg_); float* outp = (float*)outg_;
        float* const ssqb = (float*)(ws + WS_CTL) + CW_SSQ;
        switch (kind) {
        case K_PRO: phase_prologue(a, lds, tid, lane, wid, bid, G); break;
        case K_G1H: {
            pg8::Gemm g{(const bf16*)(ws + WS_XB), (const bf16*)(ws + WS_WINH) + (size_t)j * HG_IN * D, M, HG_IN, D}; pg8::StaticOrder S; S.init(M, HG_IN, G, bid);
            EpiHG E{ssqb + (size_t)(2 * l) * M, (const float*)(ws + WS_SMALL) + j * 2048, ws + WS_P, (bf16*)(ws + WS_CQ)};
            pg8::gemm_phase<EpiHG, pg8::StaticOrder, true, true>(lds, g, S, E, tid);
            if (l == 0) {
                pg8::Gemm gm{(const bf16*)(ws + WS_MEMB), (const bf16*)(ws + WS_WMEM), 1024, 2048, D}; pg8::StaticOrder Sm; Sm.init(1024, 2048, G, (bid + 128) % G);
                EpiMem Em{(const float*)(ws + WS_SMALL + 16384), INP(20), (bf16*)(ws + WS_MK), outp + O_MK};
                pg8::gemm_phase<EpiMem, pg8::StaticOrder, true, true>(lds, gm, Sm, Em, tid);
            }
        } break;
        case K_MIX: {
            const bool hg = (l & 1) == 0;
            if (hg) {
                const bf16* KF = (const bf16*)(ws + WS_P + P_SLAB); const bf16* VI = (const bf16*)(ws + WS_P + 2 * P_SLAB); const float* LF = (const float*)(ws + WS_P + 4 * P_SLAB);
                for (int u = bid; u < 1536; u += G) hg_h1_unit(u, lds, KF, VI, LF, (float*)(ws + WS_U), (float*)(ws + WS_DD), tid, lane, wid);
                for (int u = bid; u < 768; u += G) hg_sample_unit(u, lds, (const bf16*)(ws + WS_P), KF, VI, (const bf16*)(ws + WS_P + 3 * P_SLAB), LF, INP(4) + (size_t)j * 128 * 6 * 16384, outp + O_HGS + (size_t)j * 128 * 6 * 16384, (bf16*)(ws + WS_ATT), tid);
                __syncthreads();
            }
            AttnP P{ws, (const bf16*)(ws + WS_MK) + (size_t)l * 1024 * 256, INP(2) + (size_t)l * 128 * 65536, INP(3) + (size_t)l * 128 * 65536,
                    INP(5) + (size_t)j * 128 * 128 * 256, INP(6) + (size_t)j * 128 * 128 * 256, INP(17) + j * 12, outp + O_SKS + (size_t)j * 128 * 128 * 256};
            attn_phase(hg ? 768 : 0, P, lds, tid, lane, wid, bid, G);
        } break;
        case K_H2: hg_h2((const float*)(ws + WS_U), (const float*)(ws + WS_DD), (bf16*)(ws + WS_ST), outp + O_HGP + (size_t)j * 24 * 16384, bid * NTHR + tid); break;
        case K_H3: {
            for (int u = bid; u < 1536; u += G) hg_h3_unit(u, lds, (const bf16*)(ws + WS_P), (const bf16*)(ws + WS_P + P_SLAB), (const bf16*)(ws + WS_P + 2 * P_SLAB), (const bf16*)(ws + WS_P + 3 * P_SLAB),
                                                           (const float*)(ws + WS_P + 4 * P_SLAB), (const bf16*)(ws + WS_ST), (bf16*)(ws + WS_ATT), tid, lane, wid);
        } break;
        case K_G1S: {
            pg8::Gemm g{(const bf16*)(ws + WS_XB), (const bf16*)(ws + WS_WINS) + (size_t)j * SW_IN * D, M, SW_IN, D}; pg8::StaticOrder S; S.init(M, SW_IN, G, bid);
            EpiSW E{ssqb + (size_t)(2 * l) * M, (const float*)(ws + WS_SMALL + 32768) + j * 256, ws, outp, j};
            pg8::gemm_phase<EpiSW, pg8::StaticOrder, true, true>(lds, g, S, E, tid);
        } break;
        case K_G2: case K_G4: {
            const bool g4 = kind == K_G4, fin = g4 && l == 3, first = (!g4 && l == 0);
            const bf16* Ap = (const bf16*)(ws + (g4 ? WS_P : WS_ATT));
            const bf16* Bp = (const bf16*)(ws + (g4 ? WS_WFF2 + (size_t)l * D * DFF * 2 : WS_WOUT + (size_t)l * D * D * 2));
            pg8::Gemm g{Ap, Bp, M, D, g4 ? DFF : D};
            pg8::StaticOrder S; S.init(M, D, G, bid);
            float* X = (float*)(ws + WS_X);
            const float* bp = X; long sdelta = 0;
            if (first) { bp = INP(0); sdelta = (INP(1) - (size_t)MP * D) - bp; }
            float* op = X; if (fin) op = outp + O_Y;
            EpiRes E{bp, sdelta, op, fin ? nullptr : (bf16*)(ws + WS_XB), ssqb + (size_t)(2 * l + (g4 ? 2 : 1)) * M};
            pg8::gemm_phase<EpiRes, pg8::StaticOrder, true, true>(lds, g, S, E, tid);
        } break;
        case K_G3: {
            pg8::Gemm g{(const bf16*)(ws + WS_XB), (const bf16*)(ws + WS_WFF1) + (size_t)l * NFF1 * D, M, NFF1, D}; pg8::StaticOrder S; S.init(M, NFF1, G, bid);
            EpiFF1 E{ssqb + (size_t)(2 * l + 1) * M, (bf16*)(ws + WS_P)};
            pg8::gemm_phase<EpiFF1, pg8::StaticOrder, true, true>(lds, g, S, E, tid);
        } break;
        default: break;
        }
        if (p + 1 < a.ph_hi) { if (a.use_bar) xcd_barrier(bar); else __syncthreads(); }
    }
}

extern "C" void kernel_launch(void* const* d_in, const int* in_sizes, int n_in, void* d_out, int out_size, void* d_ws, size_t ws_size, hipStream_t stream) {
    static int grid = 0;
    if (grid == 0) {
        if (n_in != 24 || ws_size < WS_END) { fprintf(stderr, "kernel_launch: unexpected n_in %d or ws_size %zu (need %zu)\n", n_in, ws_size, (size_t)WS_END); grid = -1; return; }
        int dev = 0, cus = 0;
        if (hipGetDevice(&dev) != hipSuccess || hipDeviceGetAttribute(&cus, hipDeviceAttributeMultiprocessorCount, dev) != hipSuccess) { grid = -1; return; }
        if (hipFuncSetAttribute((const void*)fwd_kernel, hipFuncAttributeMaxDynamicSharedMemorySize, LDS_BYTES) != hipSuccess) { fprintf(stderr, "kernel_launch: hipFuncSetAttribute failed\n"); grid = -1; return; }
        int per_cu = 0;
        if (hipOccupancyMaxActiveBlocksPerMultiprocessor(&per_cu, (const void*)fwd_kernel, NTHR, LDS_BYTES) != hipSuccess || per_cu < 1) fprintf(stderr, "kernel_launch: occupancy query says %d blocks/CU\n", per_cu);
        (void)hipGetLastError();
        grid = cus;
    }
    if (grid < 0) return;
    (void)hipMemsetAsync((char*)d_ws + WS_CTL, 0, CTL_ZERO_BYTES, stream);
    Args a{};
    for (int i = 0; i < 24; ++i) a.in[i] = (const float*)d_in[i];
    a.out = (float*)d_out; a.ws = (unsigned char*)d_ws;
#if MK_PER_PHASE
    for (int p = 0; p < N_PHASES; ++p) { a.ph_lo = p; a.ph_hi = p + 1; a.use_bar = 0; hipLaunchKernelGGL(fwd_kernel, dim3(grid), dim3(NTHR), LDS_BYTES, stream, a); }
#else
    a.ph_lo = 0; a.ph_hi = N_PHASES; a.use_bar = 1;
    hipLaunchKernelGGL(fwd_kernel, dim3(grid), dim3(NTHR), LDS_BYTES, stream, a);
#endif
}
```

```cpp
#include <hip/hip_runtime.h>
#include <cstdio>
#include <cstdint>
namespace pg8 {
#define PG8_LAS __attribute__((address_space(3)))
typedef unsigned short bf16_t;
typedef short bf16x8 __attribute__((ext_vector_type(8)));
typedef float f32x4 __attribute__((ext_vector_type(4)));
typedef unsigned u32x4 __attribute__((ext_vector_type(4)));
constexpr int BM = 256, BK = 64, HALF = 128, HTB = HALF * BK * 2  , STAGE_BYTES = 8 * HTB, NXCD = 8, WGM = 8;

__host__ __device__ __forceinline__ int lds_byte(int r, int c) { const int st = (r >> 4) * 2 + (c >> 5), rr = r & 15, cc = c & 31, ob = rr * 64 + cc * 2; return st * 1024 + (ob ^ (((ob >> 9) & 1) << 5)); }
__host__ __device__ __forceinline__ void stage_rc(int b, int& R, int& C) { const int st = b / 1024, sb = b % 1024, swz = sb ^ (((sb >> 9) & 1) << 5); R = (st >> 1) * 16 + swz / 64; C = (st & 1) * 32 + (swz % 64) / 2; }
__host__ __device__ __forceinline__ int perm32(int rho) { const int n = rho >> 4, i = rho & 15; return 8 * (i >> 2) + 4 * n + (i & 3); }

struct Unit { int pm, pn; };
struct Gemm { const bf16_t* A; const bf16_t* Bt; int M, N, K; };

struct StaticOrder {
    int nM, nN, nwg, G, c;
    __host__ __device__ void init(int M, int N, int G_, int c_) { nM = M / BM; nN = N / BM; nwg = nM * nN; G = G_; c = c_; }
    __host__ __device__ bool next(int i, Unit& u) const { return tile((long)i * G + c, u); }
    __host__ __device__ bool tile(long L, Unit& u) const {
        if (L >= nwg) return false;
        int wgid = (int)L; { const int q = nwg / NXCD, r = nwg % NXCD, xcd = wgid % NXCD, off = wgid / NXCD; wgid = (xcd < r ? xcd * (q + 1) : r * (q + 1) + (xcd - r) * q) + off; }
        const int nig = WGM * nN, gid = wgid / nig, fm = gid * WGM, gsz = (nM - fm) < WGM ? (nM - fm) : WGM;
        u.pm = fm + ((wgid % nig) % gsz); u.pn = (wgid % nig) / gsz; return true;
    }
    __device__ __forceinline__ void a_ready(const Unit&) const {}
    __device__ __forceinline__ void done(const Unit&) const {}
};
template <class Epi, class Sched, bool ALIGN_EPI = false, bool SP2 = false>
__device__ __forceinline__ void gemm_phase(PG8_LAS unsigned char* lds, const Gemm g, const Sched& S, const Epi& E, const int tid) {
    const int wid = __builtin_amdgcn_readfirstlane(tid >> 6), lane = tid & 63, wr = wid >> 2, wc = wid & 3, fr = lane & 15, fq = lane >> 4;
    const int K = g.K, nt = K / BK;
    unsigned voffA[2], voffB[2];
#pragma unroll
    for (int i = 0; i < 2; ++i) { int R, C; stage_rc(tid * 16 + i * 8192, R, C); const int Rb = Epi::PERM ? ((R & ~31) + perm32(R & 31)) : R;
        voffA[i] = (unsigned)(R * K + C) * 2u; voffB[i] = (unsigned)(Rb * K + C) * 2u; }
    const size_t kstep = (size_t)(BK * 2);
    const size_t hstep = (size_t)HALF * K * 2;
    const size_t tstep = 2 * hstep;
    const unsigned ldsw = (unsigned)wid * 1024u;
    const int aoff = lds_byte(wr * 64 + fr, fq * 8), boff = lds_byte(wc * 32 + fr, fq * 8);
#define PG8_SA(b, h) (((b) * 2 + (h)) * HTB)
#define PG8_SB(b, h) ((4 + (b) * 2 + (h)) * HTB)
#define PG8_STAGE(bufoff, gbase, voff) do { _Pragma("unroll") for (int _i = 0; _i < 2; ++_i) \
        __builtin_amdgcn_global_load_lds((const unsigned*)((const char*)(gbase) + (voff)[_i]), (PG8_LAS unsigned*)(lds + (bufoff) + ldsw + _i * 8192), 16, 0, 0); } while (0)
#define PG8_LDA(dst, b, h) do { _Pragma("unroll") for (int m = 0; m < 4; ++m) _Pragma("unroll") for (int k = 0; k < 2; ++k) dst[m][k] = *(const PG8_LAS bf16x8*)(lds + PG8_SA(b, h) + aoff + m * 2048 + k * 1024); } while (0)
#define PG8_LDB(dst, b, h) do { _Pragma("unroll") for (int n = 0; n < 2; ++n) _Pragma("unroll") for (int k = 0; k < 2; ++k) dst[n][k] = *(const PG8_LAS bf16x8*)(lds + PG8_SB(b, h) + boff + n * 2048 + k * 1024); } while (0)
#define PG8_MMA(ai, bj, At, Bt) do { __builtin_amdgcn_s_setprio(1); _Pragma("unroll") for (int m = 0; m < 4; ++m) _Pragma("unroll") for (int n = 0; n < 2; ++n) _Pragma("unroll") for (int k = 0; k < 2; ++k) \
        acc[ai][bj][m][n] = __builtin_amdgcn_mfma_f32_16x16x32_bf16(Bt[n][k], At[m][k], acc[ai][bj][m][n], 0, 0, 0); __builtin_amdgcn_s_setprio(0); } while (0)
#define PG8_WAIT_V(n) asm volatile("s_waitcnt vmcnt(" #n ")" ::: "memory")
#define PG8_WAIT_L(n) asm volatile("s_waitcnt lgkmcnt(" #n ")" ::: "memory")
#define PG8_BAR __builtin_amdgcn_s_barrier()
#define PG8_SCHED __builtin_amdgcn_sched_barrier(0)
    Unit cur, nxt; int ui = 0;
    if (!S.next(0, cur)) return;
    PG8_LAS unsigned* ul = (PG8_LAS unsigned*)(lds + STAGE_BYTES + 1536);
    if (tid < 9) { Unit uu; uu.pm = 0; uu.pn = 0; const bool ok = tid < 8 && S.next(tid, uu); ul[tid] = ok ? ((unsigned)uu.pm | ((unsigned)uu.pn << 16)) : 0xffffffffu; }
    asm volatile("s_waitcnt lgkmcnt(0)" ::: "memory"); __builtin_amdgcn_s_barrier(); asm volatile("" ::: "memory");
    if constexpr (Epi::USE_TAB) {
        PG8_LAS float* tab = (PG8_LAS float*)(lds + STAGE_BYTES + 2048);
        for (int i = tid >> 8; i < 8; i += 2) { const unsigned w = ul[i]; if (w == 0xffffffffu) break; Unit uu; uu.pm = (int)(w & 0xffffu); uu.pn = (int)(w >> 16); tab[i * 256 + (tid & 255)] = E.row_scale(uu, tid & 255); }
        asm volatile("s_waitcnt vmcnt(0) lgkmcnt(0)" ::: "memory"); __builtin_amdgcn_s_barrier(); asm volatile("" ::: "memory");
    }
    f32x4 acc[2][2][4][2];
#pragma unroll
    for (int a = 0; a < 2; ++a)
#pragma unroll
        for (int b = 0; b < 2; ++b)
#pragma unroll
            for (int m = 0; m < 4; ++m)
#pragma unroll
                for (int n = 0; n < 2; ++n) acc[a][b][m][n] = (f32x4){0.f, 0.f, 0.f, 0.f};
    bf16x8 At[4][2], B0[2][2], B1[2][2];
    const char* cA = (const char*)g.A + (size_t)cur.pm * tstep; const char* cB = (const char*)g.Bt + (size_t)cur.pn * tstep;
    S.a_ready(cur);
    if constexpr (SP2) {
        PG8_STAGE(PG8_SB(0, 0), cB, voffB); PG8_STAGE(PG8_SB(0, 1), cB + hstep, voffB); PG8_STAGE(PG8_SA(0, 0), cA, voffA); PG8_STAGE(PG8_SA(0, 1), cA + hstep, voffA);
        if (wr == 1) PG8_BAR;
        PG8_WAIT_V(2); PG8_BAR;
        PG8_STAGE(PG8_SB(1, 0), cB + kstep, voffB); PG8_STAGE(PG8_SA(1, 0), cA + kstep, voffA); PG8_STAGE(PG8_SB(1, 1), cB + hstep + kstep, voffB);
        PG8_WAIT_V(6); PG8_BAR;
    } else {
        PG8_STAGE(PG8_SB(0, 0), cB, voffB); PG8_STAGE(PG8_SA(0, 0), cA, voffA); PG8_STAGE(PG8_SB(0, 1), cB + hstep, voffB); PG8_STAGE(PG8_SA(0, 1), cA + hstep, voffA);
        if (wr == 1) PG8_BAR;
        PG8_WAIT_V(4); PG8_BAR;
        PG8_STAGE(PG8_SB(1, 0), cB + kstep, voffB); PG8_STAGE(PG8_SA(1, 0), cA + kstep, voffA); PG8_STAGE(PG8_SB(1, 1), cB + hstep + kstep, voffB);
        PG8_WAIT_V(6); PG8_BAR;
    }
    for (;;) {
        const unsigned wn_ = (unsigned)__builtin_amdgcn_readfirstlane((int)ul[ui + 1]);
        const bool has_next = wn_ != 0xffffffffu; nxt.pm = (int)(wn_ & 0xffffu); nxt.pn = (int)(wn_ >> 16);
        const char* nA = has_next ? (const char*)g.A + (size_t)nxt.pm * tstep : cA; const char* nB = has_next ? (const char*)g.Bt + (size_t)nxt.pn * tstep : cB;
        for (int t = 0; t < nt; t += 2) {
            const bool last = (t == nt - 2);
            const char* a1 = cA + (size_t)(t + 1) * kstep;
            const char* a2 = last ? nA : cA + (size_t)(t + 2) * kstep; const char* b2 = last ? nB : cB + (size_t)(t + 2) * kstep;
            const char* a3 = a2 + kstep; const char* b3 = b2 + kstep;
            if (last && has_next) S.a_ready(nxt);
            if constexpr (SP2) {
            PG8_LDB(B0, 0, 0); PG8_LDB(B1, 0, 1); PG8_SCHED; PG8_LDA(At, 0, 0); PG8_STAGE(PG8_SA(1, 1), a1 + hstep, voffA);
            PG8_WAIT_V(8); PG8_WAIT_L(0); PG8_BAR; PG8_MMA(0, 0, At, B0); PG8_MMA(0, 1, At, B1); PG8_BAR; PG8_SCHED;
            PG8_LDA(At, 0, 1); PG8_STAGE(PG8_SB(0, 0), b2, voffB); PG8_STAGE(PG8_SB(0, 1), b2 + hstep, voffB); PG8_STAGE(PG8_SA(0, 0), a2, voffA);
            PG8_WAIT_V(8); PG8_WAIT_L(0); PG8_BAR; PG8_MMA(1, 0, At, B0); PG8_MMA(1, 1, At, B1); PG8_BAR; PG8_SCHED;
            PG8_LDB(B0, 1, 0); PG8_LDB(B1, 1, 1); PG8_SCHED; PG8_LDA(At, 1, 0); PG8_STAGE(PG8_SA(0, 1), a2 + hstep, voffA);
            PG8_WAIT_V(8); PG8_WAIT_L(0); PG8_BAR; PG8_MMA(0, 0, At, B0); PG8_MMA(0, 1, At, B1); PG8_BAR; PG8_SCHED;
            PG8_LDA(At, 1, 1); PG8_STAGE(PG8_SB(1, 0), b3, voffB); PG8_STAGE(PG8_SB(1, 1), b3 + hstep, voffB); PG8_STAGE(PG8_SA(1, 0), a3, voffA);
            PG8_WAIT_V(8); PG8_WAIT_L(0); PG8_BAR; PG8_MMA(1, 0, At, B0); PG8_MMA(1, 1, At, B1); PG8_BAR; PG8_SCHED;
            } else {
            PG8_LDB(B0, 0, 0); PG8_SCHED; PG8_LDA(At, 0, 0); PG8_STAGE(PG8_SA(1, 1), a1 + hstep, voffA);
            PG8_WAIT_L(8); PG8_BAR; PG8_WAIT_L(0); PG8_MMA(0, 0, At, B0); PG8_BAR; PG8_SCHED;
            PG8_LDB(B1, 0, 1); PG8_STAGE(PG8_SB(0, 0), b2, voffB);
            PG8_BAR; PG8_WAIT_L(0); PG8_MMA(0, 1, At, B1); PG8_BAR;
            PG8_LDA(At, 0, 1); PG8_STAGE(PG8_SA(0, 0), a2, voffA);
            PG8_BAR; PG8_WAIT_L(0); PG8_MMA(1, 0, At, B0); PG8_BAR; PG8_SCHED;
            PG8_STAGE(PG8_SB(0, 1), b2 + hstep, voffB);
            PG8_WAIT_V(6); PG8_BAR; PG8_MMA(1, 1, At, B1); PG8_BAR;
            PG8_LDB(B0, 1, 0); PG8_SCHED; PG8_LDA(At, 1, 0); PG8_STAGE(PG8_SA(0, 1), a2 + hstep, voffA);
            PG8_WAIT_L(8); PG8_BAR; PG8_WAIT_L(0); PG8_MMA(0, 0, At, B0); PG8_BAR; PG8_SCHED;
            PG8_LDB(B1, 1, 1); PG8_STAGE(PG8_SB(1, 0), b3, voffB);
            PG8_BAR; PG8_WAIT_L(0); PG8_MMA(0, 1, At, B1); PG8_BAR;
            PG8_LDA(At, 1, 1); PG8_STAGE(PG8_SA(1, 0), a3, voffA);
            PG8_BAR; PG8_WAIT_L(0); PG8_MMA(1, 0, At, B0); PG8_BAR; PG8_SCHED;
            PG8_STAGE(PG8_SB(1, 1), b3 + hstep, voffB);
            PG8_WAIT_V(6); PG8_BAR; PG8_MMA(1, 1, At, B1); PG8_BAR;
            }
        }
        if constexpr (ALIGN_EPI) { if (wr == 0) PG8_BAR; }
        if constexpr (!Epi::AFTER_DRAIN) { E(acc, cur, wr, wc, fr, fq, ui, (const PG8_LAS float*)(lds + STAGE_BYTES + 2048)); S.done(cur); }
        if (!has_next) break;
#pragma unroll
        for (int a = 0; a < 2; ++a)
#pragma unroll
            for (int b = 0; b < 2; ++b)
#pragma unroll
                for (int m = 0; m < 4; ++m)
#pragma unroll
                    for (int n = 0; n < 2; ++n) acc[a][b][m][n] = (f32x4){0.f, 0.f, 0.f, 0.f};
        cur = nxt; cA = nA; cB = nB; ++ui;
        if constexpr (ALIGN_EPI) { if (wr == 1) PG8_BAR; }
    }
    PG8_WAIT_V(0);
    if constexpr (!ALIGN_EPI) { if (wr == 0) PG8_BAR; }
    PG8_BAR;
    if constexpr (Epi::AFTER_DRAIN) { E.fused(acc, cur, wr, wc, fr, fq, lds, wid, lane); S.done(cur); }
#undef PG8_SA
#undef PG8_SB
#undef PG8_STAGE
#undef PG8_LDA
#undef PG8_LDB
#undef PG8_MMA
#undef PG8_WAIT_V
#undef PG8_WAIT_L
#undef PG8_BAR
#undef PG8_SCHED
}
}
#define GAS __attribute__((address_space(1)))
#define LAS __attribute__((address_space(3)))
typedef unsigned short bf16;
typedef unsigned v4u __attribute__((ext_vector_type(4)));
typedef float f32x4 __attribute__((ext_vector_type(4)));
typedef short bf16x8 __attribute__((ext_vector_type(8)));
typedef GAS unsigned gu32;
typedef GAS unsigned long long gu64;
#define RLX_AGENT __ATOMIC_RELAXED, __HIP_MEMORY_SCOPE_AGENT
#define LDS_WAIT() asm volatile("s_waitcnt lgkmcnt(0)" ::: "memory")
#define VM_WAIT() asm volatile("s_waitcnt vmcnt(0)" ::: "memory")
__device__ __forceinline__ unsigned long long rt() { return __builtin_amdgcn_s_memrealtime(); }
__device__ __forceinline__ unsigned f2bf(float f) { unsigned u = __builtin_bit_cast(unsigned, f); return (u + 0x7fffu + ((u >> 16) & 1u)) >> 16; }
__device__ __forceinline__ unsigned pk2(float lo, float hi) { return f2bf(lo) | (f2bf(hi) << 16); }

#define XB_TMO      128
#define XB_XCNT(j)  (256  + 64 * (j))
#define XB_XSUB(j)  (1280 + 64 * (j))
#define XB_XGEN(j)  (2304 + 64 * (j))
#define XB_TOP      3328
#define XB_TOPGEN   3392
#define XCD_BAR_WORDS 3456
#define XB_SPIN_CAP (1u << 22)

__device__ __forceinline__ unsigned xb_ld(unsigned* p)              { return __hip_atomic_load(p, __ATOMIC_RELAXED, __HIP_MEMORY_SCOPE_AGENT); }
__device__ __forceinline__ unsigned xb_add(unsigned* p, unsigned v) { return __hip_atomic_fetch_add(p, v, __ATOMIC_RELAXED, __HIP_MEMORY_SCOPE_AGENT); }
__device__ __forceinline__ unsigned xb_xcc_id() { return (unsigned)__builtin_amdgcn_s_getreg((3 << 11) | 20) & 0xFu; }
#define XB_SPIN(cond, bar) do { unsigned _sp = 0; while (cond) { __builtin_amdgcn_s_sleep(1); \
    if ((++_sp & 255u) == 0u) { if (xb_ld(&(bar)[XB_TMO])) break; if (_sp > XB_SPIN_CAP) { atomicAdd(&(bar)[XB_TMO], 1u); break; } } } } while (0)

struct XcdBarrier {
    unsigned* bar; unsigned x; int w0;
    volatile LAS unsigned* st;
};

__device__ __forceinline__ unsigned xb_lane() { return __builtin_amdgcn_mbcnt_hi(~0u, __builtin_amdgcn_mbcnt_lo(~0u, 0u)); }
__device__ __forceinline__ XcdBarrier xcd_barrier_post(unsigned* bar, volatile LAS unsigned* st, int w0) {
    XcdBarrier b; b.bar = bar; b.x = xb_xcc_id(); b.st = st; b.w0 = w0;
    if (w0 && xb_lane() == 0u) (void)xb_add(&bar[XB_XCNT(b.x)], 1u);
    return b;
}
__device__ __forceinline__ void xcd_barrier_complete(unsigned* bar, unsigned x, unsigned& nloc, unsigned& nx) {
    const unsigned G = gridDim.x * gridDim.y * gridDim.z;
    unsigned sum, cnt, mine, sp = 0u;
    for (;;) {
        sum = 0u; cnt = 0u; mine = 0u;
#pragma unroll
        for (unsigned j = 0; j < 16; ++j) { const unsigned c = xb_ld(&bar[XB_XCNT(j)]); sum += c; cnt += (c > 0u) ? 1u : 0u; mine = (j == x) ? c : mine; }
        if (sum == G) break;
        __builtin_amdgcn_s_sleep(1);
        if ((++sp & 255u) == 0u) { if (xb_ld(&bar[XB_TMO])) break; if (sp > XB_SPIN_CAP) { atomicAdd(&bar[XB_TMO], 1u); break; } }
    }
    nloc = mine > 0u ? mine : 1u; nx = cnt > 0u ? cnt : 1u;
}

__device__ __forceinline__ void xcd_barrier(const XcdBarrier& b) {
    asm volatile("s_waitcnt vmcnt(0)" ::: "memory");
    __syncthreads();
    if (b.w0 && xb_lane() == 0u) {
        unsigned* bar = b.bar;
        __builtin_amdgcn_s_waitcnt(0);
        unsigned nloc = b.st[0], nx = b.st[1];
        if (nloc == 0u) { xcd_barrier_complete(bar, b.x, nloc, nx); b.st[0] = nloc; b.st[1] = nx; }
        const unsigned old = xb_add(&bar[XB_XSUB(b.x)], 1u);
        const unsigned gen = old / nloc;
        if (old + 1u == (gen + 1u) * nloc) {
            __builtin_amdgcn_fence(__ATOMIC_RELEASE, "agent");
            asm volatile("s_waitcnt vmcnt(0)" ::: "memory");
            const unsigned og = xb_add(&bar[XB_TOP], 1u);
            const unsigned tg = og / nx;
            asm volatile("buffer_inv sc1" ::: "memory");
            if (og + 1u == (tg + 1u) * nx) xb_add(&bar[XB_TOPGEN], 1u);
            else XB_SPIN(xb_ld(&bar[XB_TOPGEN]) == tg, bar);
            xb_add(&bar[XB_XGEN(b.x)], 1u);
            asm volatile("s_waitcnt vmcnt(0)" ::: "memory");
        } else {
            asm volatile("buffer_inv sc1" ::: "memory");
            XB_SPIN(xb_ld(&bar[XB_XGEN(b.x)]) == gen, bar);
            asm volatile("s_waitcnt vmcnt(0)" ::: "memory");
        }
    }
    __syncthreads();
}

constexpr int D = 1024, SEQ = 4096, MP = 16384, MS = 512, M = MP + MS;
constexpr int TOKW = 768, MEMW = 256, HG_IN = 3328, SW_IN = 1536, DFF = 2816, NFF1 = 2 * DFF;
constexpr int NWAVES = 8, NTHR = 512;
constexpr float EPS = 1e-6f, LOG2E = 1.4426950408889634f;

constexpr size_t O_Y = 0, O_MK = 17301504, O_MV = 18350080, O_HGP = 19398656, O_HGS = 20185088, O_SKP = 45350912, O_SVP = 45613056, O_SKS = 45875200, O_SVS = 54263808;

constexpr size_t MiB = 1u << 20;
constexpr size_t WS_CTL = 0, CTL_ZERO_BYTES = 1 * MiB;
constexpr size_t WS_SMALL = 1 * MiB;
constexpr size_t WS_WINH = 2 * MiB, WS_WINS = 15 * MiB, WS_WMEM = 21 * MiB, WS_WOUT = 25 * MiB, WS_WFF1 = 33 * MiB, WS_WFF2 = 77 * MiB;
constexpr size_t WS_MEMB = 99 * MiB, WS_MK = 101 * MiB, WS_MV = 103 * MiB;
constexpr size_t WS_X = 105 * MiB, WS_XB = 171 * MiB, WS_ATT = 204 * MiB, WS_CQ = 237 * MiB;
constexpr size_t WS_P = 246 * MiB;
constexpr size_t P_SLAB = (size_t)M * 768 * 2;
constexpr size_t WS_U = 395 * MiB, WS_DD = 491 * MiB, WS_ST = 492 * MiB, WS_END = 540 * MiB;
static_assert(WS_P + 4 * P_SLAB + (size_t)M * 768 * 4 <= WS_U && WS_P + (size_t)M * DFF * 2 <= WS_U && WS_U + (size_t)1536 * 65536 <= WS_DD && WS_ST + (size_t)1536 * 32768 <= WS_END, "ws map");
static_assert(WS_X + (size_t)M * D * 4 <= WS_XB && WS_XB + (size_t)M * D * 2 <= WS_ATT && WS_ATT + (size_t)M * D * 2 <= WS_CQ && WS_CQ + (size_t)M * 256 * 2 <= WS_P, "ws map 2");
constexpr int CW_BAR = 4096;
constexpr int CW_SSQ = 32768;
static_assert((CW_SSQ + 8 * M) * 4 <= (int)CTL_ZERO_BYTES && CW_BAR + XCD_BAR_WORDS <= CW_SSQ, "ctl");

constexpr int RING_BYTES = 131072, MISC_OFF = RING_BYTES + 320, LDS_BYTES = 147456;

typedef float f32x16 __attribute__((ext_vector_type(16)));
typedef short s16x4 __attribute__((ext_vector_type(4)));
typedef float f32x2_t __attribute__((ext_vector_type(2)));
typedef __bf16 bf16x2_t __attribute__((ext_vector_type(2)));
typedef LAS unsigned char* ldsp;
typedef _Float16 lf_t;

__device__ __forceinline__ unsigned cpk(float lo, float hi) { f32x2_t v = {lo, hi}; bf16x2_t b = __builtin_convertvector(v, bf16x2_t); return __builtin_bit_cast(unsigned, b); }
__device__ __forceinline__ v4u cpk8(f32x4 a, f32x4 b) { v4u w; w.x = cpk(a[0], a[1]); w.y = cpk(a[2], a[3]); w.z = cpk(b[0], b[1]); w.w = cpk(b[2], b[3]); return w; }
__device__ __forceinline__ float bf2f(unsigned short x) { return __uint_as_float(((unsigned)x) << 16); }
__device__ __forceinline__ float fexp2(float x) { return __builtin_amdgcn_exp2f(x); }
__device__ __forceinline__ float fsigmoid(float z) { return __builtin_amdgcn_rcpf(1.0f + fexp2(-z * LOG2E)); }
__device__ __forceinline__ float fsilu(float z) { return z * fsigmoid(z); }
constexpr int SSQ_SLABS = 16;
__device__ __forceinline__ float ssq_sum(const float* ssq, int nsl, int row) {
    float s = ssq[row];
    if (nsl > 1) {
        float t[SSQ_SLABS - 1];
#pragma unroll
        for (int k = 1; k < SSQ_SLABS; ++k) t[k - 1] = ssq[(size_t)k * M + row];
#pragma unroll
        for (int k = 1; k < SSQ_SLABS; ++k) s += t[k - 1];
    }
    return s;
}
__device__ __forceinline__ float rms_r(const float* ssq, int row) { return __builtin_amdgcn_rsqf(ssq[row] * (1.0f / 1024.0f) + EPS); }
struct RowScale { float r[2][4]; };
__device__ __forceinline__ RowScale load_row_scales(const float* ssq, int nsl, int row0) {
    RowScale s;
#pragma unroll
    for (int ai = 0; ai < 2; ++ai)
#pragma unroll
        for (int m = 0; m < 4; ++m) s.r[ai][m] = ssq_sum(ssq, nsl, row0 + ai * 128 + m * 16);
#pragma unroll
    for (int ai = 0; ai < 2; ++ai)
#pragma unroll
        for (int m = 0; m < 4; ++m) s.r[ai][m] = __builtin_amdgcn_rsqf(s.r[ai][m] * (1.0f / 1024.0f) + EPS);
    asm volatile("" ::: "memory");
    return s;
}
template <bool ALL_FROM_TAB = false>
__device__ __forceinline__ RowScale get_row_scales(const float* ssq, int nsl, const pg8::Unit& u, int row0, int ui, const LAS float* tab, int wr, int fr) {
    if (!ALL_FROM_TAB && u.pm >= 64) return load_row_scales(ssq, nsl, row0);
    RowScale s;
#pragma unroll
    for (int ai = 0; ai < 2; ++ai)
#pragma unroll
        for (int m = 0; m < 4; ++m) s.r[ai][m] = tab[ui * 256 + wr * 64 + fr + ai * 128 + m * 16];
    return s;
}
__device__ __forceinline__ float wave_sum(float v) {
#pragma unroll
    for (int o = 1; o < 64; o <<= 1) v += __shfl_xor(v, o);
    return v;
}
#define MFMA32(a, b, c) __builtin_amdgcn_mfma_f32_32x32x16_bf16((a), (b), (c), 0, 0, 0)
#define MFMA16(a, b, c) __builtin_amdgcn_mfma_f32_16x16x32_bf16((a), (b), (c), 0, 0, 0)
__device__ __forceinline__ s16x4 ldtr(LAS const unsigned char* p) { return __builtin_bit_cast(s16x4, __builtin_amdgcn_ds_read_tr16_b64_v4i16((LAS s16x4*)p)); }
__device__ __forceinline__ bf16x8 cat8(s16x4 lo, s16x4 hi) { return __builtin_shufflevector(lo, hi, 0, 1, 2, 3, 4, 5, 6, 7); }

using pg8::Unit;

struct EpiHG {
    static constexpr bool PERM = true, AFTER_DRAIN = false, USE_TAB = true;
    __device__ __forceinline__ float row_scale(const Unit& u, int row) const { return __builtin_amdgcn_rsqf(ssq_sum(ssq, nsl, u.pm * 256 + row) * (1.0f / 1024.0f) + EPS); }
    const float* ssq; int nsl; const float* pt;
    unsigned char* P; bf16* CQ;
    __device__ __forceinline__ void operator()(const f32x4 (&acc)[2][2][4][2], const Unit& u, int wr, int wc, int fr, int fq, int ui, const LAS float* tab) const {
        const int row0 = u.pm * 256 + wr * 64 + fr, pn = u.pn;
        const RowScale RS = get_row_scales<true>(ssq, nsl, u, row0, ui, tab, wr, fr);
        if (pn >= 12) {
            f32x4 g[2][2];
#pragma unroll
            for (int bj = 0; bj < 2; ++bj)
#pragma unroll
                for (int n = 0; n < 2; ++n) g[bj][n] = *(const f32x4*)(pt + 1536 + 32 * bj + 8 * fq + 4 * n);
#pragma unroll
            for (int ai = 0; ai < 2; ++ai)
#pragma unroll
                for (int m = 0; m < 4; ++m) {
                    const int row = row0 + ai * 128 + m * 16; const float r = RS.r[ai][m];
                    f32x4 v[2][2]; float ss = 0.f;
#pragma unroll
                    for (int bj = 0; bj < 2; ++bj)
#pragma unroll
                        for (int n = 0; n < 2; ++n) { v[bj][n] = acc[ai][bj][m][n] * r; const f32x4 q = v[bj][n] * v[bj][n]; ss += (q[0] + q[1]) + (q[2] + q[3]); }
                    ss += __shfl_xor(ss, 16); ss += __shfl_xor(ss, 32);
                    const float rs = __builtin_amdgcn_rsqf(ss * (1.0f / 64.0f) + EPS);
#pragma unroll
                    for (int bj = 0; bj < 2; ++bj)
                        *(v4u*)(CQ + (size_t)row * 256 + wc * 64 + 32 * bj + 8 * fq) = cpk8(v[bj][0] * rs * g[bj][0], v[bj][1] * rs * g[bj][1]);
                }
            return;
        }
        const int typ = pn / 3, cb = (pn % 3) * 256 + wc * 32 + 8 * fq;
        bf16* const slab = (bf16*)(P + (size_t)typ * P_SLAB);
        lf_t* const LFp = (lf_t*)(P + 4 * P_SLAB);
        f32x4 pa[2][2];
#pragma unroll
        for (int bj = 0; bj < 2; ++bj)
#pragma unroll
            for (int n = 0; n < 2; ++n) pa[bj][n] = *(const f32x4*)(pt + (typ == 3 ? 768 : 0) + cb + bj * 128 + 4 * n);
#pragma unroll
        for (int ai = 0; ai < 2; ++ai)
#pragma unroll
            for (int m = 0; m < 4; ++m) {
                const int row = row0 + ai * 128 + m * 16; const float r = RS.r[ai][m];
#pragma unroll
                for (int bj = 0; bj < 2; ++bj) {
                    const size_t off = (size_t)row * 768 + cb + bj * 128;
                    f32x4 v[2] = {acc[ai][bj][m][0] * r, acc[ai][bj][m][1] * r};
                    if (typ == 0) {
#pragma unroll
                        for (int n = 0; n < 2; ++n)
#pragma unroll
                            for (int e = 0; e < 4; ++e) v[n][e] = fsilu(v[n][e]) * 0.08838834764831845f;
                    } else if (typ == 1) {
                        typedef _Float16 h2_t __attribute__((ext_vector_type(2))); v4u hw;
                        hw.x = __builtin_bit_cast(unsigned, (h2_t){(_Float16)v[0][0], (_Float16)v[0][1]}); hw.y = __builtin_bit_cast(unsigned, (h2_t){(_Float16)v[0][2], (_Float16)v[0][3]});
                        hw.z = __builtin_bit_cast(unsigned, (h2_t){(_Float16)v[1][0], (_Float16)v[1][1]}); hw.w = __builtin_bit_cast(unsigned, (h2_t){(_Float16)v[1][2], (_Float16)v[1][3]});
                        *(v4u*)(LFp + off) = hw;
                        continue;
                    } else if (typ == 3) {
#pragma unroll
                        for (int n = 0; n < 2; ++n)
#pragma unroll
                            for (int e = 0; e < 4; ++e) v[n][e] = fsilu(v[n][e]) * pa[bj][n][e];
                    }
                    *(v4u*)(slab + off) = cpk8(v[0], v[1]);
                }
            }
    }
};

struct EpiSW {
    static constexpr bool PERM = true, AFTER_DRAIN = false, USE_TAB = true;
    __device__ __forceinline__ float row_scale(const Unit& u, int row) const { return __builtin_amdgcn_rsqf(ssq_sum(ssq, nsl, u.pm * 256 + row) * (1.0f / 1024.0f) + EPS); }
    const float* ssq; int nsl; const float* gt;
    unsigned char* ws; float* out; int j;
    __device__ __forceinline__ void operator()(const f32x4 (&acc)[2][2][4][2], const Unit& u, int wr, int wc, int fr, int fq, int ui, const LAS float* tab) const {
        const int row0 = u.pm * 256 + wr * 64 + fr, pn = u.pn;
        const RowScale RS = get_row_scales<true>(ssq, nsl, u, row0, ui, tab, wr, fr);
        const int gi = pn < 3 ? 0 : pn - 2;
        f32x4 g[2][2];
#pragma unroll
        for (int bj = 0; bj < 2; ++bj)
#pragma unroll
            for (int n = 0; n < 2; ++n) g[bj][n] = *(const f32x4*)(gt + gi * 64 + 32 * bj + 8 * fq + 4 * n);
        bf16* const ob = (bf16*)(ws + (pn < 5 ? WS_P + (size_t)pn * 512 : WS_CQ)); const int opitch = pn < 5 ? 1280 : 256;
#pragma unroll
        for (int ai = 0; ai < 2; ++ai)
#pragma unroll
            for (int m = 0; m < 4; ++m) {
                const int row = row0 + ai * 128 + m * 16; const float r = RS.r[ai][m];
                f32x4 v[2][2]; float ss = 0.f;
#pragma unroll
                for (int bj = 0; bj < 2; ++bj)
#pragma unroll
                    for (int n = 0; n < 2; ++n) { v[bj][n] = acc[ai][bj][m][n] * r; const f32x4 q = v[bj][n] * v[bj][n]; ss += (q[0] + q[1]) + (q[2] + q[3]); }
                ss += __shfl_xor(ss, 16); ss += __shfl_xor(ss, 32);
                const float rs = (pn == 4) ? 1.0f : __builtin_amdgcn_rsqf(ss * (1.0f / 64.0f) + EPS);
                long doff = -1;
                if (pn == 3 || pn == 4) {
                    if (row < MP) { const int t = row & 4095; if (t >= 3968) doff = (long)(pn == 3 ? O_SKP : O_SVP) + (long)j * (4 * 128 * 256) + ((long)((row >> 12) * 128 + (t - 3968)) * 4 + wc) * 64; }
                    else { const int idx = row - MP; doff = (long)(pn == 3 ? O_SKS : O_SVS) + (long)j * (128 * 128 * 256) + ((long)((idx >> 2) * 128 + 124 + (idx & 3)) * 4 + wc) * 64; }
                }
#pragma unroll
                for (int bj = 0; bj < 2; ++bj) {
                    const f32x4 o0 = v[bj][0] * rs * g[bj][0], o1 = v[bj][1] * rs * g[bj][1];
                    *(v4u*)(ob + (size_t)row * opitch + wc * 64 + 32 * bj + 8 * fq) = cpk8(o0, o1);
                    if (doff >= 0) { float* dst = out + doff + 32 * bj + 8 * fq; *(f32x4*)dst = o0; *(f32x4*)(dst + 4) = o1; }
                }
            }
    }
};

struct EpiMem {
    static constexpr bool PERM = true, AFTER_DRAIN = false, USE_TAB = true;
    __device__ __forceinline__ float row_scale(const Unit& u, int row) const { return (u.pm >= 64) ? 0.f : __builtin_amdgcn_rsqf(ssq_sum(ssq, nsl, u.pm * 256 + row) * (1.0f / 1024.0f) + EPS); }
    const float* ssq; int nsl; const float* kn; bf16* MK; float* ok;
    __device__ __forceinline__ void operator()(const f32x4 (&acc)[2][2][4][2], const Unit& u, int wr, int wc, int fr, int fq, int ui, const LAS float* tab) const {
        const int row0 = u.pm * 256 + wr * 64 + fr, layer = u.pn >> 1; const bool isv = (u.pn & 1) != 0;
        const RowScale RS = get_row_scales(ssq, nsl, u, row0, ui, tab, wr, fr);
        f32x4 g[2][2];
#pragma unroll
        for (int bj = 0; bj < 2; ++bj)
#pragma unroll
            for (int n = 0; n < 2; ++n) { const f32x4 gl = *(const f32x4*)(kn + layer * 64 + 32 * bj + 8 * fq + 4 * n); g[bj][n] = isv ? (f32x4){1.f, 1.f, 1.f, 1.f} : gl; }
#pragma unroll
        for (int ai = 0; ai < 2; ++ai)
#pragma unroll
            for (int m = 0; m < 4; ++m) {
                const int row = row0 + ai * 128 + m * 16; const float r = RS.r[ai][m];
                f32x4 v[2][2]; float ss = 0.f;
#pragma unroll
                for (int bj = 0; bj < 2; ++bj)
#pragma unroll
                    for (int n = 0; n < 2; ++n) { v[bj][n] = acc[ai][bj][m][n] * r; const f32x4 q = v[bj][n] * v[bj][n]; ss += (q[0] + q[1]) + (q[2] + q[3]); }
                ss += __shfl_xor(ss, 16); ss += __shfl_xor(ss, 32);
                const float rs = isv ? 1.0f : __builtin_amdgcn_rsqf(ss * (1.0f / 64.0f) + EPS);
                const size_t off = (isv ? (size_t)1048576 : (size_t)0) + ((size_t)layer * 1024 + row) * 256 + wc * 64 + 8 * fq;
#pragma unroll
                for (int bj = 0; bj < 2; ++bj) {
                    const f32x4 o0 = v[bj][0] * rs * g[bj][0], o1 = v[bj][1] * rs * g[bj][1];
                    *(v4u*)(MK + off + 32 * bj) = cpk8(o0, o1);
                    float* dst = ok + off + 32 * bj;
                    *(f32x4*)dst = o0; *(f32x4*)(dst + 4) = o1;
                }
            }
    }
};

struct EpiFF1 {
    static constexpr bool PERM = true, AFTER_DRAIN = false, USE_TAB = true;
    __device__ __forceinline__ float row_scale(const Unit& u, int row) const { return (u.pm >= 64) ? 0.f : __builtin_amdgcn_rsqf(ssq_sum(ssq, nsl, u.pm * 256 + row) * (1.0f / 1024.0f) + EPS); }
    const float* ssq; int nsl; bf16* ACT;
    __device__ __forceinline__ void operator()(const f32x4 (&acc)[2][2][4][2], const Unit& u, int wr, int wc, int fr, int fq, int ui, const LAS float* tab) const {
        const int row0 = u.pm * 256 + wr * 64 + fr;
        const RowScale RS = get_row_scales(ssq, nsl, u, row0, ui, tab, wr, fr);
#pragma unroll
        for (int ai = 0; ai < 2; ++ai)
#pragma unroll
            for (int m = 0; m < 4; ++m) {
                const int row = row0 + ai * 128 + m * 16; const float r = RS.r[ai][m];
                f32x4 a[2];
#pragma unroll
                for (int n = 0; n < 2; ++n)
#pragma unroll
                    for (int e = 0; e < 4; ++e) a[n][e] = fsilu(acc[ai][0][m][n][e] * r) * (acc[ai][1][m][n][e] * r);
                *(v4u*)(ACT + (size_t)row * DFF + u.pn * 128 + wc * 32 + 8 * fq) = cpk8(a[0], a[1]);
            }
    }
};

struct EpiRes {
    static constexpr bool PERM = true, AFTER_DRAIN = false, USE_TAB = false;
    bf16* XB; float* yout; float* ssq_out;
    __device__ __forceinline__ void operator()(const f32x4 (&acc)[2][2][4][2], const Unit& u, int wr, int wc, int fr, int fq, int ui, const LAS float* tab) const {
        const int row0 = u.pm * 256 + wr * 64 + fr, col0 = u.pn * 256 + wc * 32 + 8 * fq;
#pragma unroll
        for (int ai = 0; ai < 2; ++ai) {
            v4u res[4][2];
#pragma unroll
            for (int m = 0; m < 4; ++m)
#pragma unroll
                for (int bj = 0; bj < 2; ++bj) res[m][bj] = *(const v4u*)(XB + (size_t)(row0 + ai * 128 + m * 16) * D + col0 + bj * 128);
            asm volatile("" ::: "memory");
#pragma unroll
            for (int m = 0; m < 4; ++m) {
                const int row = row0 + ai * 128 + m * 16; float s = 0.f;
#pragma unroll
                for (int bj = 0; bj < 2; ++bj) {
                    const size_t off = (size_t)row * D + col0 + bj * 128;
                    const v4u w = res[m][bj];
                    const f32x4 b0 = {__uint_as_float(w.x << 16), __uint_as_float(w.x & 0xffff0000u), __uint_as_float(w.y << 16), __uint_as_float(w.y & 0xffff0000u)};
                    const f32x4 b1 = {__uint_as_float(w.z << 16), __uint_as_float(w.z & 0xffff0000u), __uint_as_float(w.w << 16), __uint_as_float(w.w & 0xffff0000u)};
                    const f32x4 x0 = b0 + acc[ai][bj][m][0], x1 = b1 + acc[ai][bj][m][1];
                    if (yout) { *(f32x4*)(yout + off) = x0; *(f32x4*)(yout + off + 4) = x1; }
                    else {
                        const v4u o = cpk8(x0, x1);
                        *(v4u*)(XB + off) = o;
                        const f32x4 r0 = {__uint_as_float(o.x << 16), __uint_as_float(o.x & 0xffff0000u), __uint_as_float(o.y << 16), __uint_as_float(o.y & 0xffff0000u)};
                        const f32x4 r1 = {__uint_as_float(o.z << 16), __uint_as_float(o.z & 0xffff0000u), __uint_as_float(o.w << 16), __uint_as_float(o.w & 0xffff0000u)};
                        const f32x4 q0 = r0 * r0, q1 = r1 * r1; s += ((q0[0] + q0[1]) + (q0[2] + q0[3])) + ((q1[0] + q1[1]) + (q1[2] + q1[3]));
                    }
                }
                if (!yout) {
                    s += __shfl_xor(s, 16); s += __shfl_xor(s, 32);
                    if (fq == 0) ssq_out[(size_t)((u.pn & 3) * 4 + wc) * M + row] = s;
                }
            }
            asm volatile("" ::: "memory");
        }
    }
};

struct TrItem { const float* W; const float* gain; bf16* WT; int K, N, dst_row0, k0, n0; };
constexpr int TRSTR = 72;
__device__ __forceinline__ void tr_load(const TrItem& t, f32x4 (&v)[8], int lane) {
#pragma unroll
    for (int i = 0; i < 8; ++i) { const int kk = 8 * i + (lane >> 3); const float gk = t.gain ? t.gain[t.k0 + kk] : 1.0f; v[i] = __builtin_nontemporal_load((const f32x4*)(t.W + (size_t)(t.k0 + kk) * t.N + t.n0 + 4 * (lane & 7))) * gk; }
}
__device__ __forceinline__ void tr_store(const TrItem& t, const f32x4 (&v)[8], ldsp scr, int lane) {
#pragma unroll
    for (int i = 0; i < 8; ++i) { const int kk = 8 * i + (lane >> 3);
        *(LAS unsigned long long*)(scr + kk * TRSTR + 8 * (lane & 7)) = (unsigned long long)cpk(v[i][0], v[i][1]) | ((unsigned long long)cpk(v[i][2], v[i][3]) << 32); }
    const int i16 = lane & 15, g = lane >> 4, n = 16 * (g >> 1) + i16;
#pragma unroll
    for (int p = 0; p < 4; ++p) {
        const int kc = 2 * p + (g & 1);
        LAS const unsigned char* a = scr + (8 * kc + (i16 >> 2)) * TRSTR + (16 * (g >> 1) + 4 * (i16 & 3)) * 2;
        const bf16x8 o = cat8(ldtr(a), ldtr(a + 4 * TRSTR));
        *(bf16x8*)(t.WT + (size_t)(t.dst_row0 + n) * t.K + t.k0 + 8 * kc) = o;
    }
    LDS_WAIT(); asm volatile("" ::: "memory");
}
__device__ __forceinline__ int head_row0(int n0) { return (n0 & ~255) + 128 * ((n0 >> 5) & 1) + 32 * ((n0 >> 6) & 3); }
__device__ __forceinline__ float row_to_bf16(const float* xrow, bf16* orow, int lane) {
    const f32x4* xr = (const f32x4*)xrow + lane; float s = 0.f;
    unsigned long long* o8 = (unsigned long long*)orow + lane;
#pragma unroll
    for (int j = 0; j < 4; ++j) { const f32x4 v = xr[64 * j]; s += (v[0] * v[0] + v[1] * v[1]) + (v[2] * v[2] + v[3] * v[3]);
        o8[64 * j] = (unsigned long long)cpk(v[0], v[1]) | ((unsigned long long)cpk(v[2], v[3]) << 32); }
    return wave_sum(s);
}


constexpr int CW_CNT = 24576;
__device__ __forceinline__ void publish_tile(unsigned* cnt) {
    asm volatile("s_waitcnt vmcnt(0)" ::: "memory");
    if (xb_lane() == 0u) {
        LAS unsigned* wc = (LAS unsigned*)(unsigned)(MISC_OFF + 48);
        const unsigned old = __hip_atomic_fetch_add(wc, 1u, __ATOMIC_RELAXED, __HIP_MEMORY_SCOPE_WORKGROUP);
        if (old == 7u) {
            __hip_atomic_store(wc, 0u, __ATOMIC_RELAXED, __HIP_MEMORY_SCOPE_WORKGROUP);
            __builtin_amdgcn_fence(__ATOMIC_RELEASE, "agent");
            asm volatile("s_waitcnt vmcnt(0)" ::: "memory");
            (void)__hip_atomic_fetch_add(cnt, 8u, __ATOMIC_RELAXED, __HIP_MEMORY_SCOPE_AGENT);
        }
    }
}
#ifndef G3_SWAP
#define G3_SWAP 1
#endif
struct OrderG3 {
    pg8::StaticOrder so; int c; bool rebal; unsigned* cnt; bool swa; unsigned* cntA; int w0;
    __device__ __forceinline__ bool next(int i, Unit& u) const {
        if (!rebal) return so.next(i, u);
        if (c < 128) return i <= 5 ? so.tile((long)i * 256 + c, u) : false;
        if (c < 152) { if (i <= 4) return so.tile((long)i * 256 + c, u); if (i == 5) { const int o = c - 128; return so.tile((long)(2 + (o >> 3)) * 256 + 248 + (o & 7), u); } return false; }
        if (c < 196) { const int is = swa ? 1 : 0;
            if (i == is) { const int t = c - 152; u.pm = 64 + t / 22; u.pn = t % 22; return true; }
            return i <= (G3_SWAP ? 4 : 5) ? so.tile((long)(i < is ? i : i - 1) * 256 + c, u) : false; }
        if (c < 248) { if (i <= 4) return so.tile((long)i * 256 + c, u); if (swa && i == 5 && c < 204) return so.tile((long)256 + 248 + (c - 196), u); if (G3_SWAP && i == 5 && c >= 204) return so.tile((long)4 * 256 + (c < 244 ? c - 48 : 152 + (c - 244)), u); return false; }
        return i <= (swa ? 0 : 1) ? so.tile((long)i * 256 + c, u) : false;
    }
    __device__ __forceinline__ void a_ready(const Unit& u) const {
        if (rebal && swa && u.pm >= 64) {
            if (w0) {
                unsigned sp = 0;
                while ((unsigned)__builtin_amdgcn_readfirstlane(__hip_atomic_load(cntA + 64 * (u.pm - 64), __ATOMIC_RELAXED, __HIP_MEMORY_SCOPE_AGENT)) < 32u) { __builtin_amdgcn_s_sleep(2); if (++sp > (1u << 22)) break; }
                __builtin_amdgcn_fence(__ATOMIC_ACQUIRE, "agent");
                asm volatile("s_waitcnt vmcnt(0)" ::: "memory");
            }
            asm volatile("" ::: "memory"); __builtin_amdgcn_s_barrier(); asm volatile("" ::: "memory");
        }
    }
    __device__ __forceinline__ void done(const Unit& u) const {
        if (rebal && u.pm >= 64) publish_tile(cnt + 64 * (u.pm - 64));
    }
};
struct OneUnit {
    int pm, pn; unsigned* cnt;
    __device__ __forceinline__ bool next(int i, Unit& u) const { if (i != 0) return false; u.pm = pm; u.pn = pn; return true; }
    __device__ __forceinline__ void a_ready(const Unit&) const {}
    __device__ __forceinline__ void done(const Unit&) const {
        if (cnt) publish_tile(cnt);
    }
};

#define LAUNDER_S(x) asm volatile("" : "+s"(x))
#define INP(k) ({ int k_ = (k); LAUNDER_S(k_); (const float*)(const GAS float*)a.in[k_]; })
struct Args { const float* in[24]; float* out; unsigned char* ws; int ph_lo, ph_hi, use_bar, pad; };

struct Ctx {
    ldsp lds; int tid, lane, wid, G, bid;
    const float* const* in; float* out; unsigned char* ws;
};

__device__ __forceinline__ int layer_items(int L) { return ((L & 1) ? 768 : 1664) + 512 + 2816 + 1408; }
__device__ __forceinline__ TrItem layer_item(const Args& a, unsigned char* ws, int L, int it) {
    TrItem t; int r = it; const int j = L >> 1;
    if ((L & 1) == 0) {
        if (r < 1664) { const int kb = r / 104, nb = r % 104, n0 = nb * 32;
            t.W = INP(11) + (size_t)j * D * HG_IN; t.K = D; t.N = HG_IN; t.gain = INP(8) + L * D; t.WT = (bf16*)(ws + WS_WINH) + (size_t)j * HG_IN * D; t.dst_row0 = n0 < 3072 ? n0 : head_row0(n0); t.k0 = kb * 64; t.n0 = n0; return t; }
        r -= 1664;
    } else {
        if (r < 768) { const int kb = r / 48, nb = r % 48, n0 = nb * 32;
            t.W = INP(14) + (size_t)j * D * SW_IN; t.K = D; t.N = SW_IN; t.gain = INP(8) + L * D; t.WT = (bf16*)(ws + WS_WINS) + (size_t)j * SW_IN * D; t.dst_row0 = head_row0(n0); t.k0 = kb * 64; t.n0 = n0; return t; }
        r -= 768;
    }
    if (r < 512) { const int kb = r / 32, nb = r % 32, n0 = nb * 32;
        t.W = INP(21) + (size_t)L * D * D; t.K = D; t.N = D; t.gain = nullptr; t.WT = (bf16*)(ws + WS_WOUT) + (size_t)L * D * D; t.dst_row0 = n0; t.k0 = kb * 64; t.n0 = n0; return t; } r -= 512;
    if (r < 2816) { const int kb = r / 176, nb = r % 176, n0 = nb * 32; const int jj = n0 < DFF ? n0 : n0 - DFF;
        t.W = INP(22) + (size_t)L * D * NFF1; t.K = D; t.N = NFF1; t.gain = INP(9) + L * D; t.WT = (bf16*)(ws + WS_WFF1) + (size_t)L * NFF1 * D; t.dst_row0 = 256 * (jj >> 7) + (n0 < DFF ? 0 : 128) + (jj & 127); t.k0 = kb * 64; t.n0 = n0; return t; } r -= 2816;
    { const int kb = r / 32, nb = r % 32, n0 = nb * 32;
        t.W = INP(23) + (size_t)L * DFF * D; t.K = DFF; t.N = D; t.gain = nullptr; t.WT = (bf16*)(ws + WS_WFF2) + (size_t)L * D * DFF; t.dst_row0 = n0; t.k0 = kb * 64; t.n0 = n0; return t; }
}
__device__ __forceinline__ TrItem mem_item(const Args& a, unsigned char* ws, int r) {
    TrItem t; const int i = r / 256, q = r % 256, kb = q / 16, nb = q % 16, n0 = nb * 32;
    t.W = INP(18) + (size_t)i * D * 512; t.K = D; t.N = 512; t.gain = INP(10) + i * D; t.WT = (bf16*)(ws + WS_WMEM); t.dst_row0 = 512 * i + head_row0(n0); t.k0 = kb * 64; t.n0 = n0; return t;
}
__device__ __forceinline__ void convert_weights(const Args& a, unsigned char* ws, ldsp lds, int L, int lo, int hi, bool with_mem, int wv, int nwv, int wid, int lane) {
    ldsp scr = lds + wid * 8192;
    const int nl = hi - lo, ntot = nl + (with_mem ? 1024 : 0);
    f32x4 v[8]; TrItem cur;
    if (wv < ntot) { cur = wv < nl ? layer_item(a, ws, L, lo + wv) : mem_item(a, ws, wv - nl); tr_load(cur, v, lane); }
#pragma unroll 1
    for (int it = wv; it < ntot; it += nwv) {
        f32x4 w[8];
#pragma unroll
        for (int i = 0; i < 8; ++i) w[i] = v[i];
        const TrItem me = cur; const int nx = it + nwv;
        if (nx < ntot) { cur = nx < nl ? layer_item(a, ws, L, lo + nx) : mem_item(a, ws, nx - nl); tr_load(cur, v, lane); }
        tr_store(me, w, scr, lane);
    }
}
__device__ __forceinline__ void phase_prologue(const Args& a, ldsp lds, int tid, int lane, int wid, int bid, int G) {
    GAS unsigned char* wsg_ = (GAS unsigned char*)a.ws; LAUNDER_S(wsg_); unsigned char* ws = (unsigned char*)wsg_;
    const int gw = bid * NWAVES + wid, NGW = G * NWAVES;
    convert_weights(a, ws, lds, 0, 0, layer_items(0), true, gw, NGW, wid, lane);
    float* ssq0 = (float*)(ws + WS_CTL) + CW_SSQ;
    {
        const float* x0 = INP(0); const float* x1 = INP(1);
#pragma unroll 1
        for (int m = gw; m < M; m += 3 * NGW) {
            f32x4 v[3][4]; int mm[3];
#pragma unroll
            for (int k = 0; k < 3; ++k) {
                mm[k] = m + k * NGW; const int mc = mm[k] < M ? mm[k] : m;
                const f32x4* xr = (const f32x4*)(mc < MP ? x0 + (size_t)mc * D : x1 + (size_t)(mc - MP) * D) + lane;
#pragma unroll
                for (int j = 0; j < 4; ++j) v[k][j] = __builtin_nontemporal_load(&xr[64 * j]);
            }
#pragma unroll
            for (int k = 0; k < 3; ++k) {
                float s = 0.f;
                unsigned long long* o8 = (unsigned long long*)((bf16*)(ws + WS_XB) + (size_t)(mm[k] < M ? mm[k] : m) * D) + lane;
                if (mm[k] < M) {
#pragma unroll
                    for (int j = 0; j < 4; ++j) { const f32x4 w = v[k][j]; s += (w[0] * w[0] + w[1] * w[1]) + (w[2] * w[2] + w[3] * w[3]);
                        o8[64 * j] = (unsigned long long)cpk(w[0], w[1]) | ((unsigned long long)cpk(w[2], w[3]) << 32); }
                }
                s = wave_sum(s);
                if (lane == 0 && mm[k] < M) ssq0[mm[k]] = s;
            }
        }
    }
    float* ssqm = (float*)(ws + WS_SMALL + 16384);
    for (int m = gw; m < 1024; m += NGW) {
        const float s = row_to_bf16(INP(7) + (size_t)m * D, (bf16*)(ws + WS_MEMB) + (size_t)m * D, lane);
        if (lane == 0) ssqm[m] = s;
    }
    if (bid == 0) {
        float* pt = (float*)(ws + WS_SMALL);
        for (int c = tid; c < TOKW; c += NTHR) {
            const float r0 = INP(12)[c], r1 = INP(12)[TOKW + c], mx = fmaxf(r0, r1), e0 = __expf(r0 - mx), e1 = __expf(r1 - mx), sm1 = e1 / (e0 + e1);
            pt[c] = 0.0f; pt[2048 + c] = fminf(fmaxf(sm1, 0.0f), 0.999f);
            pt[768 + c] = INP(13)[c]; pt[2048 + 768 + c] = INP(13)[TOKW + c];
        }
        if (tid < 64) { pt[1536 + tid] = INP(19)[tid]; pt[2048 + 1536 + tid] = INP(19)[128 + tid]; }
        float* gt = (float*)(ws + WS_SMALL + 32768);
        if (tid < 128) { const int j = tid >> 6, d = tid & 63; gt[j * 256 + d] = INP(15)[j * 64 + d]; gt[j * 256 + 64 + d] = INP(16)[j * 64 + d]; gt[j * 256 + 128 + d] = 1.0f; gt[j * 256 + 192 + d] = INP(19)[(2 * j + 1) * 64 + d]; }
    }
}

constexpr int KSTR = 144;
template <int NROWS>
__device__ __forceinline__ void stage_bf16_rows2(ldsp dk, ldsp dv, const bf16* sk, const bf16* sv, long pitch, int row_lo, int tid) {
    constexpr int NIT = NROWS * 8 / NTHR;
    v4u a[NIT], b[NIT];
#pragma unroll
    for (int k = 0; k < NIT; ++k) { const int idx = tid + NTHR * k, row = idx >> 3, ch = idx & 7; const long rr = max(row_lo + row, 0);
        a[k] = *(const v4u*)(sk + rr * pitch + ch * 8); b[k] = *(const v4u*)(sv + rr * pitch + ch * 8); }
#pragma unroll
    for (int k = 0; k < NIT; ++k) { const int idx = tid + NTHR * k, row = idx >> 3, ch = idx & 7; const bool z = row_lo + row < 0;
        *(LAS v4u*)(dk + row * KSTR + ch * 16) = z ? (v4u){0u, 0u, 0u, 0u} : a[k]; *(LAS v4u*)(dv + row * KSTR + ch * 16) = z ? (v4u){0u, 0u, 0u, 0u} : b[k]; }
}
struct AttnP { unsigned char* ws; const bf16* MK; const float* cmk; const float* cmv; const float* csk; const float* csv; const float* sinks; float* oks; };
__device__ __forceinline__ void sample_attn_unit(int typ, int u, const AttnP& P, ldsp lds, int tid, int lane, int wid) {
    const int r = lane & 31, h = lane >> 5, i16 = lane & 15, g4 = lane >> 4, b = u >> 2, hx = u & 3;
    const bf16* const QKVp = (const bf16*)(P.ws + WS_P); bf16* const ATTp = (bf16*)(P.ws + WS_ATT);
    ldsp Vw = lds + wid * (32 * KSTR);
    LAS float* cm = (LAS float*)(lds + 8 * 32 * KSTR);
    LAS float* cl = cm + 128;
    LAS float* co = cl + 128;
    const int nw = typ == 1 ? 5 : 8, nq = typ == 1 ? 12 : 4;
    const float sc = 0.125f * LOG2E;
    if (wid < nw) {
        const int rr = r < nq ? r : 0;
        size_t qoff;
        if (typ == 1) qoff = ((size_t)MP + 4 * b + (rr & 3)) * 1280 + (hx * 3 + (rr >> 2)) * 64;
        else qoff = ((size_t)MP + 4 * b + rr) * 256 + hx * 64;
        const bf16* qsrc = (const bf16*)(P.ws + (typ == 1 ? WS_P : WS_CQ));
        bf16x8 qf[4];
#pragma unroll
        for (int d0 = 0; d0 < 4; ++d0) qf[d0] = *(const bf16x8*)(qsrc + qoff + d0 * 16 + h * 8);
        bf16x8 kf[4];
        const bool newrows = (typ == 1 && wid == 4);
        if (!newrows) {
            const float* kb; const float* vbp; int pitch;
            if (typ == 1) { kb = P.csk + ((size_t)b * 128 + 32 * wid) * 256 + hx * 64; vbp = P.csv + ((size_t)b * 128 + 32 * wid) * 256 + hx * 64; pitch = 256; }
            else { kb = P.cmk + ((size_t)b * 256 + 32 * wid) * 256 + hx * 64; vbp = P.cmv + ((size_t)b * 256 + 32 * wid) * 256 + hx * 64; pitch = 256; }
            f32x4 ka[4][2], va[8];
#pragma unroll
            for (int d0 = 0; d0 < 4; ++d0) { const float* p = kb + (size_t)r * pitch + d0 * 16 + h * 8; ka[d0][0] = *(const f32x4*)p; ka[d0][1] = *(const f32x4*)(p + 4); }
#pragma unroll
            for (int k = 0; k < 8; ++k) { const int idx = lane + 64 * k, row = idx >> 4, ch = idx & 15; va[k] = *(const f32x4*)(vbp + (size_t)row * pitch + ch * 4); }
#pragma unroll
            for (int d0 = 0; d0 < 4; ++d0) kf[d0] = __builtin_bit_cast(bf16x8, cpk8(ka[d0][0], ka[d0][1]));
#pragma unroll
            for (int k = 0; k < 8; ++k) { const int idx = lane + 64 * k, row = idx >> 4, ch = idx & 15;
                *(LAS unsigned long long*)(Vw + row * KSTR + ch * 8) = (unsigned long long)cpk(va[k][0], va[k][1]) | ((unsigned long long)cpk(va[k][2], va[k][3]) << 32); }
            if (typ == 1) {
                float* ok = P.oks + (size_t)b * 128 * 256 + hx * 64; float* ov = ok + (O_SVS - O_SKS);
                const int krow = 32 * wid + r;
                if (krow >= 4) {
#pragma unroll
                    for (int d0 = 0; d0 < 4; ++d0) { float* p = ok + (size_t)(krow - 4) * 256 + d0 * 16 + h * 8; *(f32x4*)p = ka[d0][0]; *(f32x4*)(p + 4) = ka[d0][1]; }
                }
#pragma unroll
                for (int k = 0; k < 8; ++k) { const int idx = lane + 64 * k, row = 32 * wid + (idx >> 4), ch = idx & 15; if (row >= 4) *(f32x4*)(ov + (size_t)(row - 4) * 256 + ch * 4) = va[k]; }
            }
        } else {
            const bf16* src = QKVp + ((size_t)MP + 4 * b + (r & 3)) * 1280 + 768 + hx * 64;
#pragma unroll
            for (int d0 = 0; d0 < 4; ++d0) { const bf16x8 t8 = *(const bf16x8*)(src + d0 * 16 + h * 8); kf[d0] = r < 4 ? t8 : (bf16x8){0, 0, 0, 0, 0, 0, 0, 0}; }
#pragma unroll
            for (int k = 0; k < 4; ++k) { const int idx = lane + 64 * k, row = idx >> 3, ch = idx & 7;
                v4u vv = {0u, 0u, 0u, 0u}; if (row < 4) vv = *(const v4u*)(QKVp + ((size_t)MP + 4 * b + row) * 1280 + 1024 + hx * 64 + ch * 8);
                *(LAS v4u*)(Vw + row * KSTR + ch * 16) = vv; }
        }
        f32x16 s;
#pragma unroll
        for (int e = 0; e < 16; ++e) s[e] = 0.f;
#pragma unroll
        for (int d0 = 0; d0 < 4; ++d0) s = MFMA32(kf[d0], qf[d0], s);
        const int tq = rr & 3;
        float mx = -1e30f;
#pragma unroll
        for (int e = 0; e < 16; ++e) { const int kidx = 32 * wid + (e & 3) + 8 * (e >> 2) + 4 * h; const bool ok = (typ != 1) || (kidx > tq && kidx <= tq + 128); const float sv = ok ? s[e] * sc : -1e30f; s[e] = sv; mx = fmaxf(mx, sv); }
        mx = fmaxf(mx, __shfl_xor(mx, 32));
        float ls = 0.f;
#pragma unroll
        for (int e = 0; e < 16; ++e) { const float pv = s[e] > -1e29f ? fexp2(s[e] - mx) : 0.f; s[e] = pv; ls += pv; }
        ls += __shfl_xor(ls, 32);
        f32x16 o[2];
#pragma unroll
        for (int e = 0; e < 16; ++e) { o[0][e] = 0.f; o[1][e] = 0.f; }
        const int vlane = (4 * h + (i16 >> 2)) * KSTR + (16 * (g4 & 1) + 4 * (i16 & 3)) * 2;
#pragma unroll
        for (int ks = 0; ks < 2; ++ks) {
            v4u pw; pw.x = cpk(s[8 * ks + 0], s[8 * ks + 1]); pw.y = cpk(s[8 * ks + 2], s[8 * ks + 3]); pw.z = cpk(s[8 * ks + 4], s[8 * ks + 5]); pw.w = cpk(s[8 * ks + 6], s[8 * ks + 7]);
            const bf16x8 pb = __builtin_bit_cast(bf16x8, pw);
#pragma unroll
            for (int d0 = 0; d0 < 2; ++d0) {
                LAS const unsigned char* vp = Vw + (16 * ks) * KSTR + d0 * 64 + vlane;
                const bf16x8 vfr = cat8(ldtr(vp), ldtr(vp + 8 * KSTR));
                o[d0] = MFMA32(vfr, pb, o[d0]);
            }
        }
        if (r < nq) {
            if (h == 0) { cm[wid * 16 + r] = mx; cl[wid * 16 + r] = ls; }
#pragma unroll
            for (int d0 = 0; d0 < 2; ++d0)
#pragma unroll
                for (int e = 0; e < 16; ++e) co[(wid * 16 + r) * 64 + d0 * 32 + (e & 3) + 8 * (e >> 2) + 4 * h] = o[d0][e];
        }
    }
    __syncthreads();
    for (int idx = tid; idx < nq * 64; idx += NTHR) {
        const int q = idx >> 6, dd = idx & 63;
        float sink2 = -1e30f; size_t doff;
        if (typ == 1) { const int head = hx * 3 + (q >> 2); sink2 = P.sinks[head] * LOG2E; doff = ((size_t)MP + 4 * b + (q & 3)) * D + head * 64 + dd; }
        else doff = ((size_t)MP + 4 * b + q) * D + TOKW + hx * 64 + dd;
        float ms = sink2;
        for (int w = 0; w < nw; ++w) ms = fmaxf(ms, cm[w * 16 + q]);
        float L = fexp2(sink2 - ms), O = 0.f;
        for (int w = 0; w < nw; ++w) { const float f = fexp2(cm[w * 16 + q] - ms); L += f * cl[w * 16 + q]; O += f * co[(w * 16 + q) * 64 + dd]; }
        ATTp[doff] = (bf16)(cpk(O / L, 0.f) & 0xffffu);
    }
    __syncthreads();
}
#ifndef MEM_FAST8
#define MEM_FAST8 1
#endif
#ifndef SWA_ALLFAST
#define SWA_ALLFAST 1
#endif
#ifndef ATT_QPRE
#define ATT_QPRE 0
#endif
__device__ __forceinline__ void attn_phase(int u_lo, int u_hi, int v_lo, int v_hi, const AttnP& P, ldsp lds, int tid0, int lane0, int wid, int bid, int G) {
    const bf16* const QKVp = (const bf16*)(P.ws + WS_P); bf16* const ATTp = (bf16*)(P.ws + WS_ATT);
    const int n1 = u_hi - u_lo, ntot = n1 + (v_hi - v_lo);
#pragma unroll 1
    for (int ix = bid; ix < ntot; ix += G) {
        const int uu = ix < n1 ? u_lo + ix : v_lo + (ix - n1);
        int tid = tid0; asm volatile("" : "+v"(tid));
        const int lane = tid & 63;
        const int r = lane & 31, h = lane >> 5, i16 = lane & 15, g4 = lane >> 4;
        const int vlane = (4 * h + (i16 >> 2)) * KSTR + (16 * (g4 & 1) + 4 * (i16 & 3)) * 2;
        const int typ = uu < 256 ? 0 : uu < 768 ? 1 : uu < 1024 ? 2 : 3;
        ldsp Ks = lds; ldsp Vs = lds + 384 * KSTR;
        int nitems = 0;
        bf16x8 qf[4]; bool qhave = false;
        if (typ == 0) {
            const int u = uu, b = u >> 6, kvh = (u >> 4) & 3, qblk = u & 15;
            if (ATT_QPRE & 1) {
                const bf16* qp = QKVp + ((size_t)b * SEQ + 256 * qblk + 32 * wid + r) * 1280 + kvh * 3 * 64;
#pragma unroll
                for (int d0 = 0; d0 < 4; ++d0) qf[d0] = *(const bf16x8*)(qp + d0 * 16 + h * 8);
                qhave = true;
            }
            const bf16* kbase = QKVp + (size_t)b * SEQ * 1280 + 768 + kvh * 64;
            stage_bf16_rows2<384>(Ks, Vs, kbase, kbase + 256, 1280, 256 * qblk - 128, tid);
            nitems = 3;
        } else if (typ == 1) {
            sample_attn_unit(1, uu - 256, P, lds, tid, lane, wid); continue;
        } else if (typ == 2) {
            const int u = uu - 768, b = u >> 6, hd = (u >> 4) & 3;
            if (ATT_QPRE & 1) {
                const bf16* qp = (const bf16*)(P.ws + WS_CQ) + ((size_t)b * SEQ + 256 * (u & 15) + 32 * wid + r) * 256 + hd * 64;
#pragma unroll
                for (int d0 = 0; d0 < 4; ++d0) qf[d0] = *(const bf16x8*)(qp + d0 * 16 + h * 8);
                qhave = true;
            }
            stage_bf16_rows2<256>(Ks, Vs, P.MK + (size_t)b * 256 * 256 + hd * 64, P.MK + 1048576 + (size_t)b * 256 * 256 + hd * 64, 256, 0, tid);
            nitems = 1;
        } else {
            sample_attn_unit(3, uu - 1024, P, lds, tid, lane, wid); continue;
        }
        __syncthreads();
#pragma unroll 1
        for (int it = 0; it < nitems; ++it) {
            size_t qoff, doff; int nkb, krow0, klo, khi, kbf = 0; float sink2; bool valid, fast = false, fast8 = false;
            if (typ == 0) {
                const int u = uu, b = u >> 6, kvh = (u >> 4) & 3, qblk = u & 15, item = wid + 8 * it, gq = item >> 3, qsub = item & 7, head = kvh * 3 + gq, q0 = 256 * qblk + 32 * qsub;
                const size_t qrow = (size_t)b * SEQ + q0 + r;
                qoff = qrow * 1280 + head * 64; doff = qrow * D + head * 64; nkb = 5; krow0 = 32 * qsub;
                klo = max(r + 1, 128 - q0); khi = r + 128; sink2 = P.sinks[head] * LOG2E; valid = true; fast = SWA_ALLFAST != 0 || q0 >= 128; kbf = q0 >= 128 ? 0 : (128 - q0) >> 5;
            } else if (typ == 1) {
                const int u = uu - 256, b = u >> 2, kvh = u & 3, rr = r < 12 ? r : 0, gq = rr >> 2, t = rr & 3, head = kvh * 3 + gq;
                const size_t qrow = (size_t)MP + 4 * b + t;
                qoff = qrow * 1280 + head * 64; doff = qrow * D + head * 64; nkb = 5; krow0 = 0;
                klo = t + 1; khi = t + 128; sink2 = P.sinks[head] * LOG2E; valid = r < 12;
            } else if (typ == 2) {
                const int u = uu - 768, b = u >> 6, hd = (u >> 4) & 3, qblk = u & 15;
                const size_t qrow = (size_t)b * SEQ + 256 * qblk + 32 * wid + r;
                qoff = qrow * 256 + hd * 64; doff = qrow * D + TOKW + hd * 64; nkb = 8; krow0 = 0; klo = 0; khi = 1 << 20; sink2 = -1e30f; valid = true; fast8 = MEM_FAST8 != 0;
            } else {
                const int u = uu - 1024, b = u >> 2, hd = u & 3;
                const size_t qrow = (size_t)MP + 4 * b + (r & 3);
                qoff = qrow * 256 + hd * 64; doff = qrow * D + TOKW + hd * 64; nkb = 8; krow0 = 0; klo = 0; khi = 1 << 20; sink2 = -1e30f; valid = r < 4;
            }
            const bf16* qsrc = (const bf16*)(P.ws + ((typ == 0 || typ == 1) ? WS_P : WS_CQ));
            if (!qhave) {
#pragma unroll
                for (int d0 = 0; d0 < 4; ++d0) qf[d0] = *(const bf16x8*)(qsrc + qoff + d0 * 16 + h * 8);
            }
            qhave = false;
            LAS const unsigned char* Kb = Ks + krow0 * KSTR; LAS const unsigned char* Vb = Vs + krow0 * KSTR;
            const float sc = 0.125f * LOG2E;
#define ATT_QK(dst, kb_) do { _Pragma("unroll") for (int e = 0; e < 16; ++e) dst[e] = 0.f; \
                _Pragma("unroll") for (int d0 = 0; d0 < 4; ++d0) { const bf16x8 kf = *(LAS const bf16x8*)(Kb + ((kb_) * 32 + r) * KSTR + d0 * 32 + h * 16); dst = MFMA32(kf, qf[d0], dst); } } while (0)
            float lsum = 0.f, mfin; f32x16 o[2];
#pragma unroll
            for (int e = 0; e < 16; ++e) { o[0][e] = 0.f; o[1][e] = 0.f; }
            if (fast) {
                f32x16 s5[5];
#pragma unroll
                for (int kb = 0; kb < 5; ++kb) ATT_QK(s5[kb], kb);
                __builtin_amdgcn_sched_barrier(0);
                if ((ATT_QPRE & 2) && it + 1 < nitems) {
#pragma unroll
                    for (int d0 = 0; d0 < 4; ++d0) qf[d0] = *(const bf16x8*)(qsrc + qoff + 64 + d0 * 16 + h * 8);
                    qhave = true;
                }
                float mx = -1e30f;
#pragma unroll
                for (int kb = 0; kb < 5; ++kb) {
#pragma unroll
                    for (int e = 0; e < 16; ++e) {
                        const int kin = (e & 3) + 8 * (e >> 2) + 4 * h;
                        float v = s5[kb][e];
                        if (kb < 4) v = (kb < kbf) ? -1e30f : v;
                        if (kb == 0) v = (kin >= r + 1) ? v : -1e30f;
                        if (kb == 4) v = (kin <= r) ? v : -1e30f;
                        s5[kb][e] = v; mx = fmaxf(mx, v);
                    }
                    if (kb == 0 || kb == 4) __builtin_amdgcn_sched_barrier(0);
                }
                mx = fmaxf(mx, __shfl_xor(mx, 32));
                mfin = fmaxf(mx * sc, sink2);
                __builtin_amdgcn_sched_barrier(0);
#pragma unroll
                for (int kb = 0; kb < 5; ++kb) {
#pragma unroll
                    for (int e = 0; e < 16; ++e) { const float pv = fexp2(__builtin_fmaf(s5[kb][e], sc, -mfin)); s5[kb][e] = pv; lsum += pv; }
#pragma unroll
                    for (int ks = 0; ks < 2; ++ks) {
                        v4u pw; pw.x = cpk(s5[kb][8 * ks + 0], s5[kb][8 * ks + 1]); pw.y = cpk(s5[kb][8 * ks + 2], s5[kb][8 * ks + 3]); pw.z = cpk(s5[kb][8 * ks + 4], s5[kb][8 * ks + 5]); pw.w = cpk(s5[kb][8 * ks + 6], s5[kb][8 * ks + 7]);
                        const bf16x8 pb = __builtin_bit_cast(bf16x8, pw);
#pragma unroll
                        for (int d0 = 0; d0 < 2; ++d0) {
                            LAS const unsigned char* vp = Vb + (kb * 32 + 16 * ks) * KSTR + d0 * 64 + vlane;
                            const bf16x8 va = cat8(ldtr(vp), ldtr(vp + 8 * KSTR));
                            o[d0] = MFMA32(va, pb, o[d0]);
                        }
                    }
                    __builtin_amdgcn_sched_barrier(0);
                }
            } else if (fast8) {
                f32x16 s8[8];
#pragma unroll
                for (int kb = 0; kb < 8; ++kb) ATT_QK(s8[kb], kb);
                __builtin_amdgcn_sched_barrier(0);
                float mx = -1e30f;
#pragma unroll
                for (int kb = 0; kb < 8; ++kb)
#pragma unroll
                    for (int e = 0; e < 16; ++e) mx = fmaxf(mx, s8[kb][e]);
                mx = fmaxf(mx, __shfl_xor(mx, 32));
                mfin = mx * sc;
                __builtin_amdgcn_sched_barrier(0);
#pragma unroll
                for (int kb = 0; kb < 8; ++kb) {
#pragma unroll
                    for (int e = 0; e < 16; ++e) { const float pv = fexp2(__builtin_fmaf(s8[kb][e], sc, -mfin)); s8[kb][e] = pv; lsum += pv; }
#pragma unroll
                    for (int ks = 0; ks < 2; ++ks) {
                        v4u pw; pw.x = cpk(s8[kb][8 * ks + 0], s8[kb][8 * ks + 1]); pw.y = cpk(s8[kb][8 * ks + 2], s8[kb][8 * ks + 3]); pw.z = cpk(s8[kb][8 * ks + 4], s8[kb][8 * ks + 5]); pw.w = cpk(s8[kb][8 * ks + 6], s8[kb][8 * ks + 7]);
                        const bf16x8 pb = __builtin_bit_cast(bf16x8, pw);
#pragma unroll
                        for (int d0 = 0; d0 < 2; ++d0) {
                            LAS const unsigned char* vp = Vb + (kb * 32 + 16 * ks) * KSTR + d0 * 64 + vlane;
                            const bf16x8 va = cat8(ldtr(vp), ldtr(vp + 8 * KSTR));
                            o[d0] = MFMA32(va, pb, o[d0]);
                        }
                    }
                    __builtin_amdgcn_sched_barrier(0);
                }
            } else {
            float mx = -1e30f;
            {
                f32x16 sc_; ATT_QK(sc_, 0);
#pragma unroll 2
                for (int kb = 0; kb < nkb; ++kb) {
                    f32x16 sn_; const int kn = kb + 1 < nkb ? kb + 1 : kb; ATT_QK(sn_, kn);
#pragma unroll
                    for (int e = 0; e < 16; ++e) { const int kidx = kb * 32 + (e & 3) + 8 * (e >> 2) + 4 * h; const bool ok = kidx >= klo && kidx <= khi; mx = fmaxf(mx, ok ? sc_[e] * sc : -1e30f); }
                    sc_ = sn_;
                }
            }
            mx = fmaxf(mx, __shfl_xor(mx, 32));
            mfin = fmaxf(mx, sink2);
            {
                f32x16 s; ATT_QK(s, 0);
#pragma unroll 2
                for (int kb = 0; kb < nkb; ++kb) {
                    f32x16 sn_; const int kn = kb + 1 < nkb ? kb + 1 : kb; ATT_QK(sn_, kn);
#pragma unroll
                    for (int e = 0; e < 16; ++e) { const int kidx = kb * 32 + (e & 3) + 8 * (e >> 2) + 4 * h; const bool ok = kidx >= klo && kidx <= khi; const float pv = ok ? fexp2(s[e] * sc - mfin) : 0.f; s[e] = pv; lsum += pv; }
#pragma unroll
                    for (int ks = 0; ks < 2; ++ks) {
                        v4u pw; pw.x = cpk(s[8 * ks + 0], s[8 * ks + 1]); pw.y = cpk(s[8 * ks + 2], s[8 * ks + 3]); pw.z = cpk(s[8 * ks + 4], s[8 * ks + 5]); pw.w = cpk(s[8 * ks + 6], s[8 * ks + 7]);
                        const bf16x8 pb = __builtin_bit_cast(bf16x8, pw);
#pragma unroll
                        for (int d0 = 0; d0 < 2; ++d0) {
                            LAS const unsigned char* vp = Vb + (kb * 32 + 16 * ks) * KSTR + d0 * 64 + vlane;
                            const bf16x8 va = cat8(ldtr(vp), ldtr(vp + 8 * KSTR));
                            o[d0] = MFMA32(va, pb, o[d0]);
                        }
                    }
                    s = sn_;
                }
            }
            }
#undef ATT_QK
            const float ltot = lsum + __shfl_xor(lsum, 32) + fexp2(sink2 - mfin);
            const float linv = 1.0f / ltot;
            if (valid) {
                bf16* dst = ATTp + doff;
#pragma unroll
                for (int d0 = 0; d0 < 2; ++d0)
#pragma unroll
                    for (int rg = 0; rg < 4; ++rg)
                        *(unsigned long long*)(dst + d0 * 32 + 8 * rg + 4 * h) = (unsigned long long)cpk(o[d0][4 * rg] * linv, o[d0][4 * rg + 1] * linv) | ((unsigned long long)cpk(o[d0][4 * rg + 2] * linv, o[d0][4 * rg + 3] * linv) << 32);
            }
        }
        __syncthreads();
    }
}

__device__ __forceinline__ void hg_sample_phase(ldsp lds, const float* lbp, const bf16* QF, const bf16* VI, const bf16* OG, const lf_t* ZF, const float* S0, float* Sout, bf16* ATT, int tid, int bid, int G) {
    const int v = tid & 127, kg = tid >> 7, lane = tid & 63, wid = tid >> 6;
    LAS float* vq = (LAS float*)lds;
    LAS float* vf = vq + 512;
    LAS float* vk = vf + 512;
    LAS float* po = vk + 512;
    LAS float* red = po + 2048;
    float Sn[32]; unsigned short qn, vvn[4], ogn[4]; float zn; int hhn = 0;
#define HGS_LOAD(u_) do { const int b_ = (u_) / 6, hh_ = (u_) % 6; \
        const float* s0_ = S0 + ((size_t)b_ * 6 + hh_) * 16384 + (size_t)(kg * 32) * 128 + v; \
        _Pragma("unroll") for (int i = 0; i < 32; ++i) Sn[i] = s0_[(size_t)i * 128]; \
        const size_t off_ = ((size_t)MP + 4 * b_ + kg) * 768 + hh_ * 128 + v; qn = QF[off_]; zn = (float)ZF[off_]; hhn = hh_; \
        _Pragma("unroll") for (int t = 0; t < 4; ++t) { const size_t o2_ = ((size_t)MP + 4 * b_ + t) * 768 + hh_ * 128 + v; vvn[t] = VI[o2_]; ogn[t] = OG[o2_]; } } while (0)
    if (bid < 768) HGS_LOAD(bid);
#pragma unroll 1
    for (int u = bid; u < 768; u += G) {
        const int b = u / 6, hh = u % 6;
        { const float lb = lbp[hhn * 128 + v], sg = fsigmoid(zn); vq[tid] = bf2f(qn); vf[tid] = lb + (1.0f - lb) * sg; vk[tid] = (1.0f - lb) * fsigmoid(-zn); }
        float S[32], vv[4], og[4];
#pragma unroll
        for (int i = 0; i < 32; ++i) S[i] = Sn[i];
#pragma unroll
        for (int t = 0; t < 4; ++t) { vv[t] = bf2f(vvn[t]); og[t] = bf2f(ogn[t]); }
        if (u + G < 768) HGS_LOAD(u + G);
        __syncthreads();
#pragma unroll
        for (int t = 0; t < 4; ++t) {
            float po_ = 0.f;
#pragma unroll
            for (int i = 0; i < 32; ++i) { const int k = kg * 32 + i; S[i] = vf[t * 128 + k] * S[i] + vk[t * 128 + k] * vv[t]; po_ += S[i] * vq[t * 128 + k]; }
            po[(t * 4 + kg) * 128 + v] = po_;
        }
        float* so = Sout + ((size_t)b * 6 + hh) * 16384 + (size_t)(kg * 32) * 128 + v;
#pragma unroll
        for (int i = 0; i < 32; ++i) so[(size_t)i * 128] = S[i];
        __syncthreads();
        float ov[4];
#pragma unroll
        for (int t = 0; t < 4; ++t) { ov[t] = (po[(t * 4 + 0) * 128 + v] + po[(t * 4 + 1) * 128 + v]) + (po[(t * 4 + 2) * 128 + v] + po[(t * 4 + 3) * 128 + v]);
            const float sq = wave_sum(ov[t] * ov[t]); if (lane == 0) red[t * 8 + wid] = sq; }
        __syncthreads();
        if (kg == 0) {
#pragma unroll
            for (int t = 0; t < 4; ++t) { const float rs = __builtin_amdgcn_rsqf((red[t * 8] + red[t * 8 + 1]) * (1.0f / 128.0f) + EPS);
                ATT[((size_t)MP + 4 * b + t) * D + hh * 128 + v] = (bf16)(cpk(ov[t] * rs * og[t], 0.f) & 0xffffu); }
        }
    }
#undef HGS_LOAD
    __syncthreads();
}

constexpr int QSTR = 272, ASTR = 144, KTSTR = 144;
struct HgPre { lf_t z[16]; v4u v[2]; };
__device__ __forceinline__ void hg_pre_load(HgPre& R, const bf16* VI, const lf_t* ZF, int unit, int tid) {
    const int n = unit & 63, bh = unit >> 6, b = bh / 6, hh = bh % 6, col0 = hh * 128, c = tid & 127, I = tid >> 7;
    const size_t m0 = (size_t)b * SEQ + 64 * n;
#pragma unroll
    for (int i = 0; i < 16; ++i) R.z[i] = ZF[(m0 + 16 * I + i) * 768 + col0 + c];
#pragma unroll
    for (int k = 0; k < 2; ++k) { const int idx = tid + NTHR * k, row = idx >> 4, ch = idx & 15; R.v[k] = *(const v4u*)(VI + (m0 + row) * 768 + col0 + ch * 8); }
}
__device__ __forceinline__ void hg_gate(float z, float lb, float& lf2, float& kf) {
    const float sg = fsigmoid(z), om = 1.0f - lb;
    lf2 = fmaxf(__builtin_amdgcn_logf(lb + om * sg), -100.0f);
    kf = om * (1.0f - sg);
}
__device__ __forceinline__ void hg_pre_vstore(const HgPre& R, ldsp Vs, int tid) {
#pragma unroll
    for (int k = 0; k < 2; ++k) { const int idx = tid + NTHR * k, row = idx >> 4, ch = idx & 15; *(LAS v4u*)(Vs + row * QSTR + ch * 16) = R.v[k]; }
}
struct HgCum { float loc[16]; float kfv[16]; float bI; float tj[4]; };
__device__ __forceinline__ void hg_cum(HgCum& F, const HgPre& R, float lb, LAS float* tot, int tid) {
    const int c = tid & 127, I = tid >> 7;
    float run = 0.f;
#pragma unroll
    for (int i = 0; i < 16; ++i) { float lf2; hg_gate((float)R.z[i], lb, lf2, F.kfv[i]); run += lf2; F.loc[i] = run; }
    tot[I * 128 + c] = run;
    __syncthreads();
#pragma unroll
    for (int j = 0; j < 4; ++j) F.tj[j] = tot[j * 128 + c];
    F.bI = 0.f;
#pragma unroll
    for (int j = 0; j < 3; ++j) if (j < I) F.bI += F.tj[j];
}
__device__ __forceinline__ bf16x8 hg_vt_frag(ldsp Vs, int vb, int ks, int lane) {
    const int h = lane >> 5, i16 = lane & 15, g = lane >> 4;
    LAS const unsigned char* p = Vs + (16 * ks + 8 * h + (i16 >> 2)) * QSTR + (vb * 32 + 16 * (g & 1) + 4 * (i16 & 3)) * 2;
    return cat8(ldtr(p), ldtr(p + 4 * QSTR));
}
__device__ __forceinline__ void hg_h1_phase(ldsp lds, const float* lbp, const bf16* VI, const lf_t* ZF, bf16* U, float* DD, int tid, int lane, int wid, int bid, int G) {
    ldsp KT = lds, Vs = lds + 128 * KTSTR; LAS float* tot = (LAS float*)(lds + 128 * KTSTR + 64 * QSTR);
    const int c = tid & 127, I = tid >> 7, r = lane & 31, h = lane >> 5, vb = wid >> 1, cb0 = 2 * (wid & 1);
    HgPre R;
    if (bid < 1536) hg_pre_load(R, VI, ZF, bid, tid);
#pragma unroll 1
    for (int unit = bid; unit < 1536; unit += G) {
        const float lb = lbp[((unit >> 6) % 6) * 128 + c];
        HgCum F; hg_cum(F, R, lb, tot, tid);
        const float total = (F.tj[0] + F.tj[1]) + (F.tj[2] + F.tj[3]);
        {
            float kt[16];
#pragma unroll
            for (int i = 0; i < 16; ++i) kt[i] = F.kfv[i] * fexp2(total - F.bI - F.loc[i]);
            v4u w0, w1;
            w0.x = cpk(kt[0], kt[1]); w0.y = cpk(kt[2], kt[3]); w0.z = cpk(kt[4], kt[5]); w0.w = cpk(kt[6], kt[7]);
            w1.x = cpk(kt[8], kt[9]); w1.y = cpk(kt[10], kt[11]); w1.z = cpk(kt[12], kt[13]); w1.w = cpk(kt[14], kt[15]);
            *(LAS v4u*)(KT + c * KTSTR + 32 * I) = w0; *(LAS v4u*)(KT + c * KTSTR + 32 * I + 16) = w1;
        }
        hg_pre_vstore(R, Vs, tid);
        if (I == 0) DD[(size_t)unit * 128 + c] = fexp2(total);
        if (unit + G < 1536) hg_pre_load(R, VI, ZF, unit + G, tid);
        __syncthreads();
        f32x16 acc[2];
#pragma unroll
        for (int e = 0; e < 16; ++e) { acc[0][e] = 0.f; acc[1][e] = 0.f; }
#pragma unroll
        for (int ks = 0; ks < 4; ++ks) {
            const bf16x8 vfr = hg_vt_frag(Vs, vb, ks, lane);
#pragma unroll
            for (int cc = 0; cc < 2; ++cc) { const bf16x8 ka = *(LAS const bf16x8*)(KT + ((cb0 + cc) * 32 + r) * KTSTR + (16 * ks + 8 * h) * 2); acc[cc] = MFMA32(ka, vfr, acc[cc]); }
        }
        bf16* Uu = U + ((size_t)unit * 128 + vb * 32 + r) * 128;
#pragma unroll
        for (int cc = 0; cc < 2; ++cc)
#pragma unroll
            for (int rg = 0; rg < 4; ++rg)
                *(unsigned long long*)(Uu + (cb0 + cc) * 32 + 8 * rg + 4 * h) = (unsigned long long)cpk(acc[cc][4 * rg], acc[cc][4 * rg + 1]) | ((unsigned long long)cpk(acc[cc][4 * rg + 2], acc[cc][4 * rg + 3]) << 32);
        __syncthreads();
    }
}
__device__ __forceinline__ void hg_h2(const bf16* U, const float* DD, bf16* ST, float* fin, int gtid) {
    if (gtid >= 24 * 4096) return;
    const int bh = gtid >> 12, e4 = gtid & 4095, v = e4 >> 5, c4 = (e4 & 31) * 4;
    f32x4 S = {0.f, 0.f, 0.f, 0.f};
#pragma unroll 1
    for (int n0 = 0; n0 < 64; n0 += 8) {
        f32x4 uu[8], dd[8]; unsigned long long uw[8];
#pragma unroll
        for (int k = 0; k < 8; ++k) { const size_t unit = (size_t)bh * 64 + n0 + k; uw[k] = *(const unsigned long long*)(U + (unit * 128 + v) * 128 + c4); dd[k] = *(const f32x4*)(DD + unit * 128 + c4); }
#pragma unroll
        for (int k = 0; k < 8; ++k) uu[k] = (f32x4){bf2f((unsigned short)uw[k]), bf2f((unsigned short)(uw[k] >> 16)), bf2f((unsigned short)(uw[k] >> 32)), bf2f((unsigned short)(uw[k] >> 48))};
#pragma unroll
        for (int k = 0; k < 8; ++k) { const size_t unit = (size_t)bh * 64 + n0 + k;
            *(unsigned long long*)(ST + (unit * 128 + v) * 128 + c4) = (unsigned long long)cpk(S[0], S[1]) | ((unsigned long long)cpk(S[2], S[3]) << 32);
            S = dd[k] * S + uu[k]; }
    }
    float* f = fin + (size_t)bh * 16384 + v;
#pragma unroll
    for (int e = 0; e < 4; ++e) f[(size_t)(c4 + e) * 128] = S[e];
}
struct HgPreQ { unsigned short q[16]; };
__device__ __forceinline__ void hg_preq_load(HgPreQ& Q, const bf16* QF, int unit, int tid) {
    const int n = unit & 63, bh = unit >> 6, b = bh / 6, hh = bh % 6, col0 = hh * 128, c = tid & 127, I = tid >> 7;
    const size_t m0 = (size_t)b * SEQ + 64 * n;
#pragma unroll
    for (int i = 0; i < 16; ++i) Q.q[i] = QF[(m0 + 16 * I + i) * 768 + col0 + c];
}
__device__ __forceinline__ void hg_h3_phase(ldsp lds, const float* lbp, const bf16* QF, const bf16* VI, const bf16* OG, const lf_t* ZF, const bf16* ST, bf16* ATT, int tid, int lane, int wid, int bid, int G) {
    ldsp QI = lds, Q0 = QI + 64 * QSTR, KX = Q0 + 64 * QSTR, Vs = KX + 160 * QSTR, AT = Vs + 64 * QSTR;
    LAS float* tot = (LAS float*)(AT + 64 * ASTR); LAS float* red = tot + 512;
    const int c = tid & 127, I = tid >> 7, r = lane & 31, h = lane >> 5, vb = wid >> 1, tb = wid & 1;
    HgPre R; HgPreQ Q;
    if (bid < 1536) { hg_pre_load(R, VI, ZF, bid, tid); hg_preq_load(Q, QF, bid, tid); }
#pragma unroll 1
    for (int unit = bid; unit < 1536; unit += G) {
        const int n = unit & 63, bh = unit >> 6, b = bh / 6, hh = bh % 6, col0 = hh * 128;
        const size_t m0 = (size_t)b * SEQ + 64 * n;
        bf16x8 sa[8]; unsigned long long ogw[4];
        {
            const bf16* Su = ST + ((size_t)unit * 128 + vb * 32 + r) * 128;
#pragma unroll
            for (int ks = 0; ks < 8; ++ks) sa[ks] = *(const bf16x8*)(Su + 16 * ks + 8 * h);
            const size_t row = m0 + tb * 32 + r;
#pragma unroll
            for (int rg = 0; rg < 4; ++rg) ogw[rg] = *(const unsigned long long*)(OG + row * 768 + col0 + vb * 32 + 8 * rg + 4 * h);
        }
        for (int idx = tid; idx < 64 * ASTR / 16; idx += NTHR) *(LAS v4u*)(AT + idx * 16) = (v4u){0u, 0u, 0u, 0u};
        HgCum F; hg_cum(F, R, lbp[hh * 128 + c], tot, tid);
        {
            float bJ[4]; bJ[0] = 0.f; bJ[1] = F.tj[0]; bJ[2] = F.tj[0] + F.tj[1]; bJ[3] = (F.tj[0] + F.tj[1]) + F.tj[2];
            const float ebI = fexp2(F.bI);
            float eJ[4];
#pragma unroll
            for (int Ip = 0; Ip < 4; ++Ip) eJ[Ip] = fexp2(bJ[Ip] - F.bI);
#pragma unroll
            for (int i = 0; i < 16; ++i) {
                const int t = 16 * I + i;
                const float qi = bf2f(Q.q[i]) * fexp2(F.loc[i]), kv = F.kfv[i] * fexp2(fminf(-F.loc[i], 80.0f));
                *(LAS bf16*)(QI + t * QSTR + c * 2) = (bf16)(cpk(qi, 0.f) & 0xffffu);
                *(LAS bf16*)(Q0 + t * QSTR + c * 2) = (bf16)(cpk(qi * ebI, 0.f) & 0xffffu);
#pragma unroll
                for (int Ip = 0; Ip < 4; ++Ip)
                    if (Ip >= I) *(LAS bf16*)(KX + (8 * Ip * (Ip + 1) + t) * QSTR + c * 2) = (bf16)(cpk(kv * eJ[Ip], 0.f) & 0xffffu);
            }
        }
        hg_pre_vstore(R, Vs, tid);
        if (unit + G < 1536) { hg_pre_load(R, VI, ZF, unit + G, tid); hg_preq_load(Q, QF, unit + G, tid); }
        __syncthreads();
        {
            const int r16 = lane & 15, kq = lane >> 4;
            for (int p = wid; p < 10; p += 8) {
                const int Ip = p < 1 ? 0 : p < 3 ? 1 : p < 6 ? 2 : 3, J = p - (Ip * (Ip + 1)) / 2;
                f32x4 a4 = {0.f, 0.f, 0.f, 0.f};
#pragma unroll
                for (int kst = 0; kst < 4; ++kst) {
                    const bf16x8 af = *(LAS const bf16x8*)(KX + (8 * Ip * (Ip + 1) + 16 * J + r16) * QSTR + (32 * kst + 8 * kq) * 2);
                    const bf16x8 bfr = *(LAS const bf16x8*)(QI + (16 * Ip + r16) * QSTR + (32 * kst + 8 * kq) * 2);
                    a4 = MFMA16(af, bfr, a4);
                }
                const int t = 16 * Ip + r16, s0 = 16 * J + 4 * kq;
                float w[4];
#pragma unroll
                for (int e = 0; e < 4; ++e) w[e] = (s0 + e <= t) ? a4[e] : 0.f;
                *(LAS unsigned long long*)(AT + t * ASTR + s0 * 2) = (unsigned long long)cpk(w[0], w[1]) | ((unsigned long long)cpk(w[2], w[3]) << 32);
            }
        }
        __syncthreads();
        f32x16 acc;
#pragma unroll
        for (int e = 0; e < 16; ++e) acc[e] = 0.f;
#pragma unroll
        for (int ks = 0; ks < 4; ++ks) {
            const bf16x8 va = hg_vt_frag(Vs, vb, ks, lane);
            const bf16x8 ab = *(LAS const bf16x8*)(AT + (tb * 32 + r) * ASTR + (16 * ks + 8 * h) * 2);
            acc = MFMA32(va, ab, acc);
        }
#pragma unroll
        for (int ks = 0; ks < 8; ++ks) {
            const bf16x8 qb = *(LAS const bf16x8*)(Q0 + (tb * 32 + r) * QSTR + (16 * ks + 8 * h) * 2);
            acc = MFMA32(sa[ks], qb, acc);
        }
        float ss = 0.f;
#pragma unroll
        for (int e = 0; e < 16; ++e) ss += acc[e] * acc[e];
        ss += __shfl_xor(ss, 32);
        if (h == 0) red[vb * 64 + tb * 32 + r] = ss;
        __syncthreads();
        const int t = tb * 32 + r;
        const float tot2 = (red[t] + red[64 + t]) + (red[128 + t] + red[192 + t]);
        const float rs = __builtin_amdgcn_rsqf(tot2 * (1.0f / 128.0f) + EPS);
        const size_t row = m0 + t;
#pragma unroll
        for (int rg = 0; rg < 4; ++rg) {
            const int v0 = vb * 32 + 8 * rg + 4 * h;
            const unsigned long long gw = ogw[rg];
            const float g0 = bf2f((unsigned short)gw), g1 = bf2f((unsigned short)(gw >> 16)), g2 = bf2f((unsigned short)(gw >> 32)), g3 = bf2f((unsigned short)(gw >> 48));
            *(unsigned long long*)(ATT + row * D + col0 + v0) = (unsigned long long)cpk(acc[4 * rg] * rs * g0, acc[4 * rg + 1] * rs * g1) | ((unsigned long long)cpk(acc[4 * rg + 2] * rs * g2, acc[4 * rg + 3] * rs * g3) << 32);
        }
        __syncthreads();
    }
}

__device__ __forceinline__ void hg_h1p_phase(ldsp lds, const float* lbp, const bf16* VI, const lf_t* ZF, bf16* U, float* DD, int tid, int lane, int wid, int bid, int G) {
    ldsp KT = lds, Vs = lds + 128 * KTSTR; LAS float* tot = (LAS float*)(lds + 128 * KTSTR + 64 * QSTR); LAS float* ttot = tot + 512;
    const int c = tid & 127, I = tid >> 7, r = lane & 31, h = lane >> 5, vb = wid >> 1, cb0 = 2 * (wid & 1);
    HgPre R;
    if (bid < 768) hg_pre_load(R, VI, ZF, 2 * bid, tid);
#pragma unroll 1
    for (int pr = bid; pr < 768; pr += G) {
        const float lb = lbp[((pr >> 5) % 6) * 128 + c];
        f32x16 acc[2];
#pragma unroll
        for (int e = 0; e < 16; ++e) { acc[0][e] = 0.f; acc[1][e] = 0.f; }
        float dsum = 0.f;
#pragma unroll 1
        for (int k = 0; k < 2; ++k) {
            HgCum F; hg_cum(F, R, lb, tot, tid);
            const float total = (F.tj[0] + F.tj[1]) + (F.tj[2] + F.tj[3]);
            {
                float kt[16];
#pragma unroll
                for (int i = 0; i < 16; ++i) kt[i] = F.kfv[i] * fexp2(total - F.bI - F.loc[i]);
                v4u w0, w1;
                w0.x = cpk(kt[0], kt[1]); w0.y = cpk(kt[2], kt[3]); w0.z = cpk(kt[4], kt[5]); w0.w = cpk(kt[6], kt[7]);
                w1.x = cpk(kt[8], kt[9]); w1.y = cpk(kt[10], kt[11]); w1.z = cpk(kt[12], kt[13]); w1.w = cpk(kt[14], kt[15]);
                *(LAS v4u*)(KT + c * KTSTR + 32 * I) = w0; *(LAS v4u*)(KT + c * KTSTR + 32 * I + 16) = w1;
            }
            hg_pre_vstore(R, Vs, tid);
            if (I == 0) ttot[c] = fexp2(total);
            dsum += total;
            { const int nu = (k == 0) ? 2 * pr + 1 : 2 * (pr + G); if (nu < 1536) hg_pre_load(R, VI, ZF, nu, tid); }
            __syncthreads();
            if (k == 1) {
#pragma unroll
                for (int cc = 0; cc < 2; ++cc)
#pragma unroll
                    for (int e = 0; e < 16; ++e) acc[cc][e] *= ttot[(cb0 + cc) * 32 + (e & 3) + 8 * (e >> 2) + 4 * h];
            }
#pragma unroll
            for (int ks = 0; ks < 4; ++ks) {
                const bf16x8 vfr = hg_vt_frag(Vs, vb, ks, lane);
#pragma unroll
                for (int cc = 0; cc < 2; ++cc) { const bf16x8 ka = *(LAS const bf16x8*)(KT + ((cb0 + cc) * 32 + r) * KTSTR + (16 * ks + 8 * h) * 2); acc[cc] = MFMA32(ka, vfr, acc[cc]); }
            }
            __syncthreads();
        }
        if (I == 0) DD[(size_t)pr * 128 + c] = fexp2(dsum);
        bf16* Uu = U + ((size_t)pr * 128 + vb * 32 + r) * 128;
#pragma unroll
        for (int cc = 0; cc < 2; ++cc)
#pragma unroll
            for (int rg = 0; rg < 4; ++rg)
                *(unsigned long long*)(Uu + (cb0 + cc) * 32 + 8 * rg + 4 * h) = (unsigned long long)cpk(acc[cc][4 * rg], acc[cc][4 * rg + 1]) | ((unsigned long long)cpk(acc[cc][4 * rg + 2], acc[cc][4 * rg + 3]) << 32);
    }
}
__device__ __forceinline__ void hg_h2p(const bf16* U, const float* DD, bf16* ST, float* fin, int gtid) {
    if (gtid >= 24 * 4096) return;
    const int bh = gtid >> 12, e4 = gtid & 4095, v = e4 >> 5, c4 = (e4 & 31) * 4;
    f32x4 S = {0.f, 0.f, 0.f, 0.f};
#pragma unroll 1
    for (int n0 = 0; n0 < 32; n0 += 8) {
        f32x4 uu[8], dd[8]; unsigned long long uw[8];
#pragma unroll
        for (int k = 0; k < 8; ++k) { const size_t unit = (size_t)bh * 32 + n0 + k; uw[k] = *(const unsigned long long*)(U + (unit * 128 + v) * 128 + c4); dd[k] = *(const f32x4*)(DD + unit * 128 + c4); }
#pragma unroll
        for (int k = 0; k < 8; ++k) uu[k] = (f32x4){bf2f((unsigned short)uw[k]), bf2f((unsigned short)(uw[k] >> 16)), bf2f((unsigned short)(uw[k] >> 32)), bf2f((unsigned short)(uw[k] >> 48))};
#pragma unroll
        for (int k = 0; k < 8; ++k) { const size_t unit = (size_t)bh * 32 + n0 + k;
            *(unsigned long long*)(ST + (unit * 128 + v) * 128 + c4) = (unsigned long long)cpk(S[0], S[1]) | ((unsigned long long)cpk(S[2], S[3]) << 32);
            S = dd[k] * S + uu[k]; }
    }
    float* f = fin + (size_t)bh * 16384 + v;
#pragma unroll
    for (int e = 0; e < 4; ++e) f[(size_t)(c4 + e) * 128] = S[e];
}
__device__ __forceinline__ void hg_h3p_phase(ldsp lds, const float* lbp, const bf16* QF, const bf16* VI, const bf16* OG, const lf_t* ZF, const bf16* ST, bf16* ATT, int tid, int lane, int wid, int bid, int G) {
    ldsp QI = lds, Q0 = QI + 64 * QSTR, KX = Q0 + 64 * QSTR, Vs = KX + 160 * QSTR, AT = Vs + 64 * QSTR;
    LAS float* tot = (LAS float*)(AT + 64 * ASTR); LAS float* red = tot + 512; LAS float* ttot = red + 256;
    ldsp KT = (ldsp)(ttot + 128);
    const int c = tid & 127, I = tid >> 7, r = lane & 31, h = lane >> 5, vb = wid >> 1, tb = wid & 1;
    HgPre R; HgPreQ Q;
    if (bid < 768) { hg_pre_load(R, VI, ZF, 2 * bid, tid); hg_preq_load(Q, QF, 2 * bid, tid); }
#pragma unroll 1
    for (int pr = bid; pr < 768; pr += G) {
        const int bh = pr >> 5, b = bh / 6, hh = bh % 6, col0 = hh * 128;
        const float lb = lbp[hh * 128 + c];
        f32x16 Sreg[4];
        {
            const bf16* Sp = ST + ((size_t)pr * 128 + vb * 32 + r) * 128;
#pragma unroll
            for (int cb = 0; cb < 4; ++cb)
#pragma unroll
                for (int rg = 0; rg < 4; ++rg) { const unsigned long long w = *(const unsigned long long*)(Sp + cb * 32 + 8 * rg + 4 * h);
                    Sreg[cb][4 * rg] = bf2f((unsigned short)w); Sreg[cb][4 * rg + 1] = bf2f((unsigned short)(w >> 16)); Sreg[cb][4 * rg + 2] = bf2f((unsigned short)(w >> 32)); Sreg[cb][4 * rg + 3] = bf2f((unsigned short)(w >> 48)); }
        }
#pragma unroll 1
        for (int k = 0; k < 2; ++k) {
            const int n = (2 * pr + k) & 63;
            const size_t m0 = (size_t)b * SEQ + 64 * n;
            unsigned long long ogw[4];
            {
                const size_t row = m0 + tb * 32 + r;
#pragma unroll
                for (int rg = 0; rg < 4; ++rg) ogw[rg] = *(const unsigned long long*)(OG + row * 768 + col0 + vb * 32 + 8 * rg + 4 * h);
            }
            for (int idx = tid; idx < 64 * ASTR / 16; idx += NTHR) *(LAS v4u*)(AT + idx * 16) = (v4u){0u, 0u, 0u, 0u};
            HgCum F; hg_cum(F, R, lb, tot, tid);
            {
                float bJ[4]; bJ[0] = 0.f; bJ[1] = F.tj[0]; bJ[2] = F.tj[0] + F.tj[1]; bJ[3] = (F.tj[0] + F.tj[1]) + F.tj[2];
                const float ebI = fexp2(F.bI), total = bJ[3] + F.tj[3];
                if (I == 0) ttot[c] = fexp2(total);
                float eJ[4];
#pragma unroll
                for (int Ip = 0; Ip < 4; ++Ip) eJ[Ip] = fexp2(bJ[Ip] - F.bI);
                float kt[16];
#pragma unroll
                for (int i = 0; i < 16; ++i) {
                    const int t = 16 * I + i;
                    const float qi = bf2f(Q.q[i]) * fexp2(F.loc[i]), kv = F.kfv[i] * fexp2(fminf(-F.loc[i], 80.0f));
                    kt[i] = F.kfv[i] * fexp2(total - F.bI - F.loc[i]);
                    *(LAS bf16*)(QI + t * QSTR + c * 2) = (bf16)(cpk(qi, 0.f) & 0xffffu);
                    *(LAS bf16*)(Q0 + t * QSTR + c * 2) = (bf16)(cpk(qi * ebI, 0.f) & 0xffffu);
#pragma unroll
                    for (int Ip = 0; Ip < 4; ++Ip)
                        if (Ip >= I) *(LAS bf16*)(KX + (8 * Ip * (Ip + 1) + t) * QSTR + c * 2) = (bf16)(cpk(kv * eJ[Ip], 0.f) & 0xffffu);
                }
                if (k == 0) {
                    v4u w0, w1;
                    w0.x = cpk(kt[0], kt[1]); w0.y = cpk(kt[2], kt[3]); w0.z = cpk(kt[4], kt[5]); w0.w = cpk(kt[6], kt[7]);
                    w1.x = cpk(kt[8], kt[9]); w1.y = cpk(kt[10], kt[11]); w1.z = cpk(kt[12], kt[13]); w1.w = cpk(kt[14], kt[15]);
                    *(LAS v4u*)(KT + c * KTSTR + 32 * I) = w0; *(LAS v4u*)(KT + c * KTSTR + 32 * I + 16) = w1;
                }
            }
            hg_pre_vstore(R, Vs, tid);
            { const int nu = (k == 0) ? 2 * pr + 1 : 2 * (pr + G); if (nu < 1536) { hg_pre_load(R, VI, ZF, nu, tid); hg_preq_load(Q, QF, nu, tid); } }
            __syncthreads();
            {
                const int r16 = lane & 15, kq = lane >> 4;
                for (int p = wid; p < 10; p += 8) {
                    const int Ip = p < 1 ? 0 : p < 3 ? 1 : p < 6 ? 2 : 3, J = p - (Ip * (Ip + 1)) / 2;
                    f32x4 a4 = {0.f, 0.f, 0.f, 0.f};
#pragma unroll
                    for (int kst = 0; kst < 4; ++kst) {
                        const bf16x8 af = *(LAS const bf16x8*)(KX + (8 * Ip * (Ip + 1) + 16 * J + r16) * QSTR + (32 * kst + 8 * kq) * 2);
                        const bf16x8 bfr = *(LAS const bf16x8*)(QI + (16 * Ip + r16) * QSTR + (32 * kst + 8 * kq) * 2);
                        a4 = MFMA16(af, bfr, a4);
                    }
                    const int t = 16 * Ip + r16, s0 = 16 * J + 4 * kq;
                    float w[4];
#pragma unroll
                    for (int e = 0; e < 4; ++e) w[e] = (s0 + e <= t) ? a4[e] : 0.f;
                    *(LAS unsigned long long*)(AT + t * ASTR + s0 * 2) = (unsigned long long)cpk(w[0], w[1]) | ((unsigned long long)cpk(w[2], w[3]) << 32);
                }
            }
            __syncthreads();
            f32x16 acc;
#pragma unroll
            for (int e = 0; e < 16; ++e) acc[e] = 0.f;
#pragma unroll
            for (int ks = 0; ks < 4; ++ks) {
                const bf16x8 va = hg_vt_frag(Vs, vb, ks, lane);
                const bf16x8 ab = *(LAS const bf16x8*)(AT + (tb * 32 + r) * ASTR + (16 * ks + 8 * h) * 2);
                acc = MFMA32(va, ab, acc);
            }
#pragma unroll
            for (int cb = 0; cb < 4; ++cb)
#pragma unroll
                for (int s = 0; s < 2; ++s) {
                    v4u pw; pw.x = cpk(Sreg[cb][8 * s + 0], Sreg[cb][8 * s + 1]); pw.y = cpk(Sreg[cb][8 * s + 2], Sreg[cb][8 * s + 3]); pw.z = cpk(Sreg[cb][8 * s + 4], Sreg[cb][8 * s + 5]); pw.w = cpk(Sreg[cb][8 * s + 6], Sreg[cb][8 * s + 7]);
                    LAS const unsigned char* qp = Q0 + (tb * 32 + r) * QSTR + (32 * cb + 16 * s + 4 * h) * 2;
                    const bf16x8 qb = cat8(*(LAS const s16x4*)qp, *(LAS const s16x4*)(qp + 16));
                    acc = MFMA32(__builtin_bit_cast(bf16x8, pw), qb, acc);
                }
            float ss = 0.f;
#pragma unroll
            for (int e = 0; e < 16; ++e) ss += acc[e] * acc[e];
            ss += __shfl_xor(ss, 32);
            if (h == 0) red[vb * 64 + tb * 32 + r] = ss;
            if (k == 0) {
#pragma unroll
                for (int cb = 0; cb < 4; ++cb)
#pragma unroll
                    for (int e = 0; e < 16; ++e) Sreg[cb][e] *= ttot[cb * 32 + (e & 3) + 8 * (e >> 2) + 4 * h];
#pragma unroll
                for (int ks = 0; ks < 4; ++ks) {
                    const bf16x8 vfr = hg_vt_frag(Vs, vb, ks, lane);
#pragma unroll
                    for (int cb = 0; cb < 4; ++cb) { const bf16x8 ka = *(LAS const bf16x8*)(KT + (cb * 32 + r) * KTSTR + (16 * ks + 8 * h) * 2); Sreg[cb] = MFMA32(ka, vfr, Sreg[cb]); }
                }
            }
            __syncthreads();
            const int t = tb * 32 + r;
            const float tot2 = (red[t] + red[64 + t]) + (red[128 + t] + red[192 + t]);
            const float rs = __builtin_amdgcn_rsqf(tot2 * (1.0f / 128.0f) + EPS);
            const size_t row = m0 + t;
#pragma unroll
            for (int rg = 0; rg < 4; ++rg) {
                const int v0 = vb * 32 + 8 * rg + 4 * h;
                const unsigned long long gw = ogw[rg];
                const float g0 = bf2f((unsigned short)gw), g1 = bf2f((unsigned short)(gw >> 16)), g2 = bf2f((unsigned short)(gw >> 32)), g3 = bf2f((unsigned short)(gw >> 48));
                *(unsigned long long*)(ATT + row * D + col0 + v0) = (unsigned long long)cpk(acc[4 * rg] * rs * g0, acc[4 * rg + 1] * rs * g1) | ((unsigned long long)cpk(acc[4 * rg + 2] * rs * g2, acc[4 * rg + 3] * rs * g3) << 32);
            }
            __syncthreads();
        }
    }
}

#ifndef MK_PER_PHASE
#define MK_PER_PHASE 0
#endif
constexpr int N_PHASES = 25;
#ifndef HG_PAIRS
#define HG_PAIRS 1
#endif
#ifndef SWA_LATE
#define SWA_LATE 1
#endif
#ifndef HG_LATE
#define HG_LATE 1
#endif
#ifndef HG_MEM_KEEP
#define HG_MEM_KEEP 0
#endif
#ifndef SWA_MEM_KEEP
#define SWA_MEM_KEEP 0
#endif
#ifndef SWA_KEEP
#define SWA_KEEP 0
#endif
enum Kind { K_PRO = 0, K_G1H, K_MIX, K_H2, K_H3, K_G1S, K_G2, K_G3, K_G4 };

__global__ void __launch_bounds__(NTHR, 2) fwd_kernel(Args a) {
    extern __shared__ __attribute__((aligned(16))) unsigned char lds_raw[];
    ldsp lds = (ldsp)lds_raw;
    const int tid0 = threadIdx.x, bid0 = blockIdx.x, G0 = gridDim.x;
    const int wid0 = __builtin_amdgcn_readfirstlane(tid0 >> 6);
    volatile LAS unsigned* MISC = (volatile LAS unsigned*)(lds + MISC_OFF);
    for (int u = tid0; u < (LDS_BYTES - RING_BYTES) / 4; u += NTHR) ((LAS unsigned*)(lds + RING_BYTES))[u] = 0u;
    __syncthreads();
    XcdBarrier bar; bar.bar = (unsigned*)(a.ws + WS_CTL) + CW_BAR; bar.x = 0; bar.st = nullptr; bar.w0 = wid0 == 0;
    if (a.use_bar) bar = xcd_barrier_post((unsigned*)(a.ws + WS_CTL) + CW_BAR, MISC + 8, wid0 == 0);

#ifndef PROBE_PAR
#define PROBE_PAR 0
#endif
#ifndef PROBE_LATE
#define PROBE_LATE 0
#endif
#ifndef PROBE_REP_MASK
#define PROBE_REP_MASK 0
#endif
    int rep = 0;
#pragma unroll 1
    for (int p = a.ph_lo; p < a.ph_hi;) {
        int l = 0, st = 0, kind = K_PRO;
        if (p > 0) {
            const int q = p - 1;
            if (q < 7) { l = 0; st = q; } else if (q < 12) { l = 1; st = q - 7; } else if (q < 19) { l = 2; st = q - 12; } else { l = 3; st = q - 19; }
            if ((l & 1) == 0) kind = st == 0 ? K_G1H : st == 1 ? K_MIX : st == 2 ? K_H2 : st == 3 ? K_H3 : st == 4 ? K_G2 : st == 5 ? K_G3 : K_G4;
            else kind = st == 0 ? K_G1S : st == 1 ? K_MIX : st == 2 ? K_G2 : st == 3 ? K_G3 : K_G4;
        }
        int bid = bid0, G = G0; LAUNDER_S(bid); LAUNDER_S(G);
        const int j = l >> 1; const bool rebal = (G == 256);
        int wv_ = wid0; LAUNDER_S(wv_);
        int tid = wv_ * 64 + (int)xb_lane(); asm volatile("" : "+v"(tid));
        const int lane = tid & 63, wid = __builtin_amdgcn_readfirstlane(tid >> 6);
        GAS unsigned char* wsg_ = (GAS unsigned char*)a.ws; LAUNDER_S(wsg_); unsigned char* ws = (unsigned char*)wsg_;
        GAS float* outg_ = (GAS float*)a.out; LAUNDER_S(outg_); float* outp = (float*)outg_;
        float* const ssqb = (float*)(ws + WS_CTL) + CW_SSQ;
        float* const ssqp = (float*)(ws + WS_X);
#define SSQ_ARR(i_) ((i_) == 0 ? ssqb : ssqp + (size_t)((i_) - 1) * SSQ_SLABS * M)
#define SSQ_NSL(i_) ((i_) == 0 ? 1 : SSQ_SLABS)
        int kconv = 0;
        bool late = false; const int pb = (bid >> 4) * 8 + (bid & 7); const int kind0 = kind;
        const bool ovl = rebal && ((l & 1) ? SWA_LATE != 0 : HG_LATE != 0);
        if (ovl && kind == K_G2 && ((bid >> 3) & 1)) { kind = K_MIX; late = true; }
        switch (kind) {
        case K_PRO: phase_prologue(a, lds, tid, lane, wid, bid, G); break;
        case K_G1H: {
            pg8::Gemm g{(const bf16*)(ws + WS_XB), (const bf16*)(ws + WS_WINH) + (size_t)j * HG_IN * D, M, HG_IN, D}; pg8::StaticOrder S; S.init(M, HG_IN, G, bid);
            EpiHG E{SSQ_ARR(2 * l), SSQ_NSL(2 * l), (const float*)(ws + WS_SMALL) + j * 2048, ws + WS_P, (bf16*)(ws + WS_CQ)};
            pg8::gemm_phase<EpiHG, pg8::StaticOrder, true, true>(lds, g, S, E, tid);
            if (l == 0) {
                pg8::Gemm gm{(const bf16*)(ws + WS_MEMB), (const bf16*)(ws + WS_WMEM), 1024, 2048, D}; pg8::StaticOrder Sm; Sm.init(1024, 2048, G, (bid + 128) % G);
                EpiMem Em{(const float*)(ws + WS_SMALL + 16384), 1, INP(20), (bf16*)(ws + WS_MK), outp + O_MK};
                pg8::gemm_phase<EpiMem, pg8::StaticOrder, true, true>(lds, gm, Sm, Em, tid);
            }
            kconv = 1;
        } break;
        case K_MIX: case K_H2: {
            const bool hg = (l & 1) == 0, h2 = kind == K_H2;
            int rk = bid, nrk = G; if (late) { rk = pb; nrk = 128; }
            if (hg && !h2) {
                const bf16* VI = (const bf16*)(ws + WS_P + 2 * P_SLAB); const lf_t* ZF = (const lf_t*)(ws + WS_P + 4 * P_SLAB); const float* lbp = (const float*)(ws + WS_SMALL) + j * 2048;
                if (!late) { if (HG_PAIRS) hg_h1p_phase(lds, lbp, VI, ZF, (bf16*)(ws + WS_U), (float*)(ws + WS_DD), tid, lane, wid, bid, G); else hg_h1_phase(lds, lbp, VI, ZF, (bf16*)(ws + WS_U), (float*)(ws + WS_DD), tid, lane, wid, bid, G); }
                if (late || !ovl) hg_sample_phase(lds, lbp, (const bf16*)(ws + WS_P), VI, (const bf16*)(ws + WS_P + 3 * P_SLAB), ZF, INP(4) + (size_t)j * 128 * 6 * 16384, outp + O_HGS + (size_t)j * 128 * 6 * 16384, (bf16*)(ws + WS_ATT), tid, rk, nrk);
                __syncthreads();
            }
            if (h2) { if (HG_PAIRS) hg_h2p((const bf16*)(ws + WS_U), (const float*)(ws + WS_DD), (bf16*)(ws + WS_ST), outp + O_HGP + (size_t)j * 24 * 16384, bid * NTHR + tid); else hg_h2((const bf16*)(ws + WS_U), (const float*)(ws + WS_DD), (bf16*)(ws + WS_ST), outp + O_HGP + (size_t)j * 24 * 16384, bid * NTHR + tid); }
            AttnP P{ws, (const bf16*)(ws + WS_MK) + (size_t)l * 1024 * 256, INP(2) + (size_t)l * 128 * 65536, INP(3) + (size_t)l * 128 * 65536,
                    INP(5) + (size_t)j * 128 * 128 * 256, INP(6) + (size_t)j * 128 * 128 * 256, INP(17) + j * 12, outp + O_SKS + (size_t)j * 128 * 128 * 256};
            int ulo = 0, uhi = 1536, vlo = 0, vhi = 0;
            if (hg && rebal) {
                if (late) { ulo = 1024 + HG_MEM_KEEP; }
                else if (!h2) { ulo = 1024; uhi = ovl ? 1024 + HG_MEM_KEEP : 1536; }
                else { ulo = 768; uhi = 1024; }
            } else if (hg) { if (!h2) ulo = 768; else uhi = 0; }
            else if (ovl) {
                if (late) { ulo = 256 + SWA_KEEP; uhi = 768; vlo = 1024 + SWA_MEM_KEEP; vhi = 1536; }
                else { uhi = 256 + SWA_KEEP; vlo = 768; vhi = 1024 + SWA_MEM_KEEP; }
            }
            attn_phase(ulo, uhi, vlo, vhi, P, lds, tid, lane, wid, rk, nrk);
        } break;
        case K_H3: {
            if (HG_PAIRS) hg_h3p_phase(lds, (const float*)(ws + WS_SMALL) + j * 2048, (const bf16*)(ws + WS_P), (const bf16*)(ws + WS_P + 2 * P_SLAB), (const bf16*)(ws + WS_P + 3 * P_SLAB),
                        (const lf_t*)(ws + WS_P + 4 * P_SLAB), (const bf16*)(ws + WS_ST), (bf16*)(ws + WS_ATT), tid, lane, wid, bid, G);
            else hg_h3_phase(lds, (const float*)(ws + WS_SMALL) + j * 2048, (const bf16*)(ws + WS_P), (const bf16*)(ws + WS_P + 2 * P_SLAB), (const bf16*)(ws + WS_P + 3 * P_SLAB),
                        (const lf_t*)(ws + WS_P + 4 * P_SLAB), (const bf16*)(ws + WS_ST), (bf16*)(ws + WS_ATT), tid, lane, wid, bid, G);
        } break;
        case K_G1S: {
            pg8::Gemm g{(const bf16*)(ws + WS_XB), (const bf16*)(ws + WS_WINS) + (size_t)j * SW_IN * D, M, SW_IN, D}; pg8::StaticOrder S; S.init(M, SW_IN, G, bid);
            EpiSW E{SSQ_ARR(2 * l), SSQ_NSL(2 * l), (const float*)(ws + WS_SMALL + 32768) + j * 256, ws, outp, j};
            pg8::gemm_phase<EpiSW, pg8::StaticOrder, true, true>(lds, g, S, E, tid);
            kconv = 1;
        } break;
        case K_G2: case K_G4: {
            const bool g4 = kind == K_G4, fin = g4 && l == 3;
            const bf16* Ap = (const bf16*)(ws + (g4 ? WS_P : WS_ATT));
            const bf16* Bp = (const bf16*)(ws + (g4 ? WS_WFF2 + (size_t)l * D * DFF * 2 : WS_WOUT + (size_t)l * D * D * 2));
            pg8::Gemm g{Ap, Bp, M, D, g4 ? DFF : D};
            const bool halfg = ovl && !g4;
            pg8::StaticOrder S; S.init(rebal ? MP : M, D, halfg ? 128 : G, halfg ? pb : bid);
            float* yo = nullptr; if (fin) yo = outp + O_Y;
            EpiRes E{(bf16*)(ws + WS_XB), yo, SSQ_ARR(2 * l + (g4 ? 2 : 1))};
            pg8::gemm_phase<EpiRes, pg8::StaticOrder, true, true>(lds, g, S, E, tid);
        } break;
        case K_G3: {
            pg8::Gemm g{(const bf16*)(ws + WS_XB), (const bf16*)(ws + WS_WFF1) + (size_t)l * NFF1 * D, M, NFF1, D};
            const bool swa = true;
            unsigned* cntA = (unsigned*)(ws + WS_CTL) + CW_CNT + 1024 + 128 * l;
            if (rebal && swa && bid >= 248 && rep == 0) {
                const int sidx = bid - 248, panel = sidx >> 2;
                pg8::Gemm g2{(const bf16*)(ws + WS_ATT), (const bf16*)(ws + WS_WOUT) + (size_t)l * D * D, M, D, D};
                OneUnit S2{64 + panel, sidx & 3, cntA + 64 * panel};
                EpiRes E2{(bf16*)(ws + WS_XB), nullptr, SSQ_ARR(2 * l + 1)};
                pg8::gemm_phase<EpiRes, OneUnit, true, true>(lds, g2, S2, E2, tid);
                __syncthreads();
            }
            OrderG3 S; S.c = bid; S.rebal = rebal; S.cnt = (unsigned*)(ws + WS_CTL) + CW_CNT + 128 * l; S.swa = swa; S.cntA = cntA; S.w0 = wid == 0; S.so.init(rebal ? MP : M, NFF1, G, bid);
            EpiFF1 E{SSQ_ARR(2 * l + 1), SSQ_SLABS, (bf16*)(ws + WS_P)};
            pg8::gemm_phase<EpiFF1, OrderG3, true, true>(lds, g, S, E, tid);
        } break;
        default: break;
        }
        {
            int cvL = -1, lo = 0, hi = 0, first = 0, last = G;
            if (G == 256) {
                if (kind == K_G1H && l == 0) { cvL = 1; lo = 0; hi = 3300; first = 160; last = 256; }
                else if (kind == K_H2 && l == 0) { cvL = 1; lo = 3300; hi = 4600; first = 192; last = 248; }
                else if (kind == K_G3 && l == 0) { cvL = 1; lo = 4600; hi = 5504; first = G3_SWAP ? 152 : 204; last = G3_SWAP ? 196 : 248; }
                else if (kind == K_G1S && l == 1) { cvL = 2; lo = 0; hi = 5000; first = 140; last = 256; }
                else if (kind == K_G3 && l == 1) { cvL = 2; lo = 5000; hi = 6400; first = G3_SWAP ? 152 : 204; last = G3_SWAP ? 196 : 248; }
                else if (kind == K_G1H && l == 2) { cvL = 3; lo = 0; hi = 5504; first = 90; last = 256; }
            } else if (kconv && l < 3) { cvL = l + 1; lo = 0; hi = layer_items(l + 1); }
            if (cvL >= 0 && bid >= first && bid < last) { __syncthreads(); convert_weights(a, ws, lds, cvL, lo, hi, false, (bid - first) * NWAVES + wid, (last - first) * NWAVES, wid, lane); }
        }
        if (rebal && bid >= 248 && kind == K_G3 && rep == 0) {
            const bool g4 = kind == K_G3, fin = g4 && l == 3;
            const int sidx = bid - 248, panel = sidx >> 2;
            if (g4) {
                if (wid == 0) {
                    unsigned* cw = (unsigned*)(ws + WS_CTL) + CW_CNT + 128 * l + 64 * panel; unsigned sp = 0;
                    while ((unsigned)__builtin_amdgcn_readfirstlane(__hip_atomic_load(cw, __ATOMIC_RELAXED, __HIP_MEMORY_SCOPE_AGENT)) < 176u) { __builtin_amdgcn_s_sleep(8); if (++sp > (1u << 22)) break; }
                    __builtin_amdgcn_fence(__ATOMIC_ACQUIRE, "agent");
                    asm volatile("s_waitcnt vmcnt(0)" ::: "memory");
                }
                __syncthreads();
            }
            const bf16* Ap = (const bf16*)(ws + (g4 ? WS_P : WS_ATT));
            const bf16* Bp = (const bf16*)(ws + (g4 ? WS_WFF2 + (size_t)l * D * DFF * 2 : WS_WOUT + (size_t)l * D * D * 2));
            pg8::Gemm g{Ap, Bp, M, D, g4 ? DFF : D};
            OneUnit S{64 + panel, sidx & 3, nullptr};
            float* yo = nullptr; if (fin) yo = outp + O_Y;
            EpiRes E{(bf16*)(ws + WS_XB), yo, SSQ_ARR(2 * l + (g4 ? 2 : 1))};
            pg8::gemm_phase<EpiRes, OneUnit, true, true>(lds, g, S, E, tid);
        }
        if (PROBE_LATE != 0 && late && rep == 0 && ((PROBE_LATE == 1 && (l & 1)) || (PROBE_LATE == 2 && !(l & 1)))) { rep = 1; __syncthreads(); continue; }
        if (PROBE_REP_MASK != 0 && rep == 0 && ((PROBE_REP_MASK >> kind0) & 1) && (PROBE_PAR == 0 || (PROBE_PAR == 1 && (l & 1)) || (PROBE_PAR == 2 && !(l & 1)))) { rep = 1; if (a.use_bar) xcd_barrier(bar); else __syncthreads(); continue; }
        rep = 0; ++p;
        if (p < a.ph_hi) { if (a.use_bar) xcd_barrier(bar); else __syncthreads(); }
    }
}

extern "C" void kernel_launch(void* const* d_in, const int* in_sizes, int n_in, void* d_out, int out_size, void* d_ws, size_t ws_size, hipStream_t stream) {
    static int grid = 0;
    if (grid == 0) {
        if (n_in != 24 || ws_size < WS_END) { fprintf(stderr, "kernel_launch: unexpected n_in %d or ws_size %zu (need %zu)\n", n_in, ws_size, (size_t)WS_END); grid = -1; return; }
        int dev = 0, cus = 0;
        if (hipGetDevice(&dev) != hipSuccess || hipDeviceGetAttribute(&cus, hipDeviceAttributeMultiprocessorCount, dev) != hipSuccess) { grid = -1; return; }
        if (hipFuncSetAttribute((const void*)fwd_kernel, hipFuncAttributeMaxDynamicSharedMemorySize, LDS_BYTES) != hipSuccess) { fprintf(stderr, "kernel_launch: hipFuncSetAttribute failed\n"); grid = -1; return; }
        int per_cu = 0;
        if (hipOccupancyMaxActiveBlocksPerMultiprocessor(&per_cu, (const void*)fwd_kernel, NTHR, LDS_BYTES) != hipSuccess || per_cu < 1) fprintf(stderr, "kernel_launch: occupancy query says %d blocks/CU\n", per_cu);
        (void)hipGetLastError();
        grid = cus;
    }
    if (grid < 0) return;
    (void)hipMemsetAsync((char*)d_ws + WS_CTL, 0, CTL_ZERO_BYTES, stream);
    Args a{};
    for (int i = 0; i < 24; ++i) a.in[i] = (const float*)d_in[i];
    a.out = (float*)d_out; a.ws = (unsigned char*)d_ws;
#if MK_PER_PHASE
    for (int p = 0; p < N_PHASES; ++p) { a.ph_lo = p; a.ph_hi = p + 1; a.use_bar = 0; hipLaunchKernelGGL(fwd_kernel, dim3(grid), dim3(NTHR), LDS_BYTES, stream, a); }
#else
    a.ph_lo = 0; a.ph_hi = N_PHASES; a.use_bar = 1;
    hipLaunchKernelGGL(fwd_kernel, dim3(grid), dim3(NTHR), LDS_BYTES, stream, a);
#endif
}
```

```cpp
#include <hip/hip_runtime.h>
#include <cstdio>
#include <cstdint>
namespace pg8 {
#define PG8_LAS __attribute__((address_space(3)))
typedef unsigned short bf16_t;
typedef short bf16x8 __attribute__((ext_vector_type(8)));
typedef float f32x4 __attribute__((ext_vector_type(4)));
typedef unsigned u32x4 __attribute__((ext_vector_type(4)));
constexpr int BM = 256, BK = 64, HALF = 128, HTB = HALF * BK * 2  , STAGE_BYTES = 8 * HTB, NXCD = 8, WGM = 8;

__host__ __device__ __forceinline__ int lds_byte(int r, int c) { const int st = (r >> 4) * 2 + (c >> 5), rr = r & 15, cc = c & 31, ob = rr * 64 + cc * 2; return st * 1024 + (ob ^ (((ob >> 9) & 1) << 5)); }
__host__ __device__ __forceinline__ void stage_rc(int b, int& R, int& C) { const int st = b / 1024, sb = b % 1024, swz = sb ^ (((sb >> 9) & 1) << 5); R = (st >> 1) * 16 + swz / 64; C = (st & 1) * 32 + (swz % 64) / 2; }
__host__ __device__ __forceinline__ int perm32(int rho) { const int n = rho >> 4, i = rho & 15; return 8 * (i >> 2) + 4 * n + (i & 3); }

struct Unit { int pm, pn; };
struct Gemm { const bf16_t* A; const bf16_t* Bt; int M, N, K; };

struct StaticOrder {
    int nM, nN, nwg, G, c;
    __host__ __device__ void init(int M, int N, int G_, int c_) { nM = M / BM; nN = N / BM; nwg = nM * nN; G = G_; c = c_; }
    __host__ __device__ bool next(int i, Unit& u) const { return tile((long)i * G + c, u); }
    __host__ __device__ bool tile(long L, Unit& u) const {
        if (L >= nwg) return false;
        int wgid = (int)L; { const int q = nwg / NXCD, r = nwg % NXCD, xcd = wgid % NXCD, off = wgid / NXCD; wgid = (xcd < r ? xcd * (q + 1) : r * (q + 1) + (xcd - r) * q) + off; }
        const int nig = WGM * nN, gid = wgid / nig, fm = gid * WGM, gsz = (nM - fm) < WGM ? (nM - fm) : WGM;
        u.pm = fm + ((wgid % nig) % gsz); u.pn = (wgid % nig) / gsz; return true;
    }
    __device__ __forceinline__ void a_ready(const Unit&) const {}
    __device__ __forceinline__ void done(const Unit&) const {}
};
template <class Epi, class Sched, bool ALIGN_EPI = false, bool SP2 = false>
__device__ __forceinline__ void gemm_phase(PG8_LAS unsigned char* lds, const Gemm g, const Sched& S, const Epi& E, const int tid) {
    const int wid = __builtin_amdgcn_readfirstlane(tid >> 6), lane = tid & 63, wr = wid >> 2, wc = wid & 3, fr = lane & 15, fq = lane >> 4;
    const int K = g.K, nt = K / BK;
    unsigned voffA[2], voffB[2];
#pragma unroll
    for (int i = 0; i < 2; ++i) { int R, C; stage_rc(tid * 16 + i * 8192, R, C); const int Rb = Epi::PERM ? ((R & ~31) + perm32(R & 31)) : R;
        voffA[i] = (unsigned)(R * K + C) * 2u; voffB[i] = (unsigned)(Rb * K + C) * 2u; }
    const size_t kstep = (size_t)(BK * 2);
    const size_t hstep = (size_t)HALF * K * 2;
    const size_t tstep = 2 * hstep;
    const unsigned ldsw = (unsigned)wid * 1024u;
    const int aoff = lds_byte(wr * 64 + fr, fq * 8), boff = lds_byte(wc * 32 + fr, fq * 8);
#define PG8_SA(b, h) (((b) * 2 + (h)) * HTB)
#define PG8_SB(b, h) ((4 + (b) * 2 + (h)) * HTB)
#define PG8_STAGE(bufoff, gbase, voff) do { _Pragma("unroll") for (int _i = 0; _i < 2; ++_i) \
        __builtin_amdgcn_global_load_lds((const unsigned*)((const char*)(gbase) + (voff)[_i]), (PG8_LAS unsigned*)(lds + (bufoff) + ldsw + _i * 8192), 16, 0, 0); } while (0)
#define PG8_LDA(dst, b, h) do { _Pragma("unroll") for (int m = 0; m < 4; ++m) _Pragma("unroll") for (int k = 0; k < 2; ++k) dst[m][k] = *(const PG8_LAS bf16x8*)(lds + PG8_SA(b, h) + aoff + m * 2048 + k * 1024); } while (0)
#define PG8_LDB(dst, b, h) do { _Pragma("unroll") for (int n = 0; n < 2; ++n) _Pragma("unroll") for (int k = 0; k < 2; ++k) dst[n][k] = *(const PG8_LAS bf16x8*)(lds + PG8_SB(b, h) + boff + n * 2048 + k * 1024); } while (0)
#define PG8_MMA(ai, bj, At, Bt) do { __builtin_amdgcn_s_setprio(1); _Pragma("unroll") for (int m = 0; m < 4; ++m) _Pragma("unroll") for (int n = 0; n < 2; ++n) _Pragma("unroll") for (int k = 0; k < 2; ++k) \
        acc[ai][bj][m][n] = __builtin_amdgcn_mfma_f32_16x16x32_bf16(Bt[n][k], At[m][k], acc[ai][bj][m][n], 0, 0, 0); __builtin_amdgcn_s_setprio(0); } while (0)
#define PG8_WAIT_V(n) asm volatile("s_waitcnt vmcnt(" #n ")" ::: "memory")
#define PG8_WAIT_L(n) asm volatile("s_waitcnt lgkmcnt(" #n ")" ::: "memory")
#define PG8_BAR __builtin_amdgcn_s_barrier()
#define PG8_SCHED __builtin_amdgcn_sched_barrier(0)
    Unit cur, nxt; int ui = 0;
    if (!S.next(0, cur)) return;
    if constexpr (Epi::USE_TAB) {
        PG8_LAS float* tab = (PG8_LAS float*)(lds + STAGE_BYTES + 2048);
        Unit uu;
        for (int i = tid >> 8; i < 8 && S.next(i, uu); i += 2) tab[i * 256 + (tid & 255)] = E.row_scale(uu, tid & 255);
        asm volatile("s_waitcnt vmcnt(0) lgkmcnt(0)" ::: "memory"); __builtin_amdgcn_s_barrier(); asm volatile("" ::: "memory");
    }
    f32x4 acc[2][2][4][2];
#pragma unroll
    for (int a = 0; a < 2; ++a)
#pragma unroll
        for (int b = 0; b < 2; ++b)
#pragma unroll
            for (int m = 0; m < 4; ++m)
#pragma unroll
                for (int n = 0; n < 2; ++n) acc[a][b][m][n] = (f32x4){0.f, 0.f, 0.f, 0.f};
    bf16x8 At[4][2], B0[2][2], B1[2][2];
    const char* cA = (const char*)g.A + (size_t)cur.pm * tstep; const char* cB = (const char*)g.Bt + (size_t)cur.pn * tstep;
    S.a_ready(cur);
    if constexpr (SP2) {
        PG8_STAGE(PG8_SB(0, 0), cB, voffB); PG8_STAGE(PG8_SB(0, 1), cB + hstep, voffB); PG8_STAGE(PG8_SA(0, 0), cA, voffA); PG8_STAGE(PG8_SA(0, 1), cA + hstep, voffA);
        if (wr == 1) PG8_BAR;
        PG8_WAIT_V(2); PG8_BAR;
        PG8_STAGE(PG8_SB(1, 0), cB + kstep, voffB); PG8_STAGE(PG8_SA(1, 0), cA + kstep, voffA); PG8_STAGE(PG8_SB(1, 1), cB + hstep + kstep, voffB);
        PG8_WAIT_V(6); PG8_BAR;
    } else {
        PG8_STAGE(PG8_SB(0, 0), cB, voffB); PG8_STAGE(PG8_SA(0, 0), cA, voffA); PG8_STAGE(PG8_SB(0, 1), cB + hstep, voffB); PG8_STAGE(PG8_SA(0, 1), cA + hstep, voffA);
        if (wr == 1) PG8_BAR;
        PG8_WAIT_V(4); PG8_BAR;
        PG8_STAGE(PG8_SB(1, 0), cB + kstep, voffB); PG8_STAGE(PG8_SA(1, 0), cA + kstep, voffA); PG8_STAGE(PG8_SB(1, 1), cB + hstep + kstep, voffB);
        PG8_WAIT_V(6); PG8_BAR;
    }
    for (;;) {
        const bool has_next = S.next(ui + 1, nxt);
        const char* nA = has_next ? (const char*)g.A + (size_t)nxt.pm * tstep : cA; const char* nB = has_next ? (const char*)g.Bt + (size_t)nxt.pn * tstep : cB;
        for (int t = 0; t < nt; t += 2) {
            const bool last = (t == nt - 2);
            const char* a1 = cA + (size_t)(t + 1) * kstep;
            const char* a2 = last ? nA : cA + (size_t)(t + 2) * kstep; const char* b2 = last ? nB : cB + (size_t)(t + 2) * kstep;
            const char* a3 = a2 + kstep; const char* b3 = b2 + kstep;
            if (last && has_next) S.a_ready(nxt);
            if constexpr (SP2) {
            PG8_LDB(B0, 0, 0); PG8_LDB(B1, 0, 1); PG8_SCHED; PG8_LDA(At, 0, 0); PG8_STAGE(PG8_SA(1, 1), a1 + hstep, voffA);
            PG8_WAIT_V(8); PG8_WAIT_L(0); PG8_BAR; PG8_MMA(0, 0, At, B0); PG8_MMA(0, 1, At, B1); PG8_BAR; PG8_SCHED;
            PG8_LDA(At, 0, 1); PG8_STAGE(PG8_SB(0, 0), b2, voffB); PG8_STAGE(PG8_SB(0, 1), b2 + hstep, voffB); PG8_STAGE(PG8_SA(0, 0), a2, voffA);
            PG8_WAIT_V(8); PG8_WAIT_L(0); PG8_BAR; PG8_MMA(1, 0, At, B0); PG8_MMA(1, 1, At, B1); PG8_BAR; PG8_SCHED;
            PG8_LDB(B0, 1, 0); PG8_LDB(B1, 1, 1); PG8_SCHED; PG8_LDA(At, 1, 0); PG8_STAGE(PG8_SA(0, 1), a2 + hstep, voffA);
            PG8_WAIT_V(8); PG8_WAIT_L(0); PG8_BAR; PG8_MMA(0, 0, At, B0); PG8_MMA(0, 1, At, B1); PG8_BAR; PG8_SCHED;
            PG8_LDA(At, 1, 1); PG8_STAGE(PG8_SB(1, 0), b3, voffB); PG8_STAGE(PG8_SB(1, 1), b3 + hstep, voffB); PG8_STAGE(PG8_SA(1, 0), a3, voffA);
            PG8_WAIT_V(8); PG8_WAIT_L(0); PG8_BAR; PG8_MMA(1, 0, At, B0); PG8_MMA(1, 1, At, B1); PG8_BAR; PG8_SCHED;
            } else {
            PG8_LDB(B0, 0, 0); PG8_SCHED; PG8_LDA(At, 0, 0); PG8_STAGE(PG8_SA(1, 1), a1 + hstep, voffA);
            PG8_WAIT_L(8); PG8_BAR; PG8_WAIT_L(0); PG8_MMA(0, 0, At, B0); PG8_BAR; PG8_SCHED;
            PG8_LDB(B1, 0, 1); PG8_STAGE(PG8_SB(0, 0), b2, voffB);
            PG8_BAR; PG8_WAIT_L(0); PG8_MMA(0, 1, At, B1); PG8_BAR;
            PG8_LDA(At, 0, 1); PG8_STAGE(PG8_SA(0, 0), a2, voffA);
            PG8_BAR; PG8_WAIT_L(0); PG8_MMA(1, 0, At, B0); PG8_BAR; PG8_SCHED;
            PG8_STAGE(PG8_SB(0, 1), b2 + hstep, voffB);
            PG8_WAIT_V(6); PG8_BAR; PG8_MMA(1, 1, At, B1); PG8_BAR;
            PG8_LDB(B0, 1, 0); PG8_SCHED; PG8_LDA(At, 1, 0); PG8_STAGE(PG8_SA(0, 1), a2 + hstep, voffA);
            PG8_WAIT_L(8); PG8_BAR; PG8_WAIT_L(0); PG8_MMA(0, 0, At, B0); PG8_BAR; PG8_SCHED;
            PG8_LDB(B1, 1, 1); PG8_STAGE(PG8_SB(1, 0), b3, voffB);
            PG8_BAR; PG8_WAIT_L(0); PG8_MMA(0, 1, At, B1); PG8_BAR;
            PG8_LDA(At, 1, 1); PG8_STAGE(PG8_SA(1, 0), a3, voffA);
            PG8_BAR; PG8_WAIT_L(0); PG8_MMA(1, 0, At, B0); PG8_BAR; PG8_SCHED;
            PG8_STAGE(PG8_SB(1, 1), b3 + hstep, voffB);
            PG8_WAIT_V(6); PG8_BAR; PG8_MMA(1, 1, At, B1); PG8_BAR;
            }
        }
        if constexpr (ALIGN_EPI) { if (wr == 0) PG8_BAR; }
        if constexpr (!Epi::AFTER_DRAIN) { E(acc, cur, wr, wc, fr, fq, ui, (const PG8_LAS float*)(lds + STAGE_BYTES + 2048)); S.done(cur); }
        if (!has_next) break;
#pragma unroll
        for (int a = 0; a < 2; ++a)
#pragma unroll
            for (int b = 0; b < 2; ++b)
#pragma unroll
                for (int m = 0; m < 4; ++m)
#pragma unroll
                    for (int n = 0; n < 2; ++n) acc[a][b][m][n] = (f32x4){0.f, 0.f, 0.f, 0.f};
        cur = nxt; cA = nA; cB = nB; ++ui;
        if constexpr (ALIGN_EPI) { if (wr == 1) PG8_BAR; }
    }
    PG8_WAIT_V(0);
    if constexpr (!ALIGN_EPI) { if (wr == 0) PG8_BAR; }
    PG8_BAR;
    if constexpr (Epi::AFTER_DRAIN) { E.fused(acc, cur, wr, wc, fr, fq, lds, wid, lane); S.done(cur); }
#undef PG8_SA
#undef PG8_SB
#undef PG8_STAGE
#undef PG8_LDA
#undef PG8_LDB
#undef PG8_MMA
#undef PG8_WAIT_V
#undef PG8_WAIT_L
#undef PG8_BAR
#undef PG8_SCHED
}
}
#define GAS __attribute__((address_space(1)))
#define LAS __attribute__((address_space(3)))
typedef unsigned short bf16;
typedef unsigned v4u __attribute__((ext_vector_type(4)));
typedef float f32x4 __attribute__((ext_vector_type(4)));
typedef short bf16x8 __attribute__((ext_vector_type(8)));
typedef GAS unsigned gu32;
typedef GAS unsigned long long gu64;
#define RLX_AGENT __ATOMIC_RELAXED, __HIP_MEMORY_SCOPE_AGENT
#define LDS_WAIT() asm volatile("s_waitcnt lgkmcnt(0)" ::: "memory")
#define VM_WAIT() asm volatile("s_waitcnt vmcnt(0)" ::: "memory")
__device__ __forceinline__ unsigned long long rt() { return __builtin_amdgcn_s_memrealtime(); }
__device__ __forceinline__ unsigned f2bf(float f) { unsigned u = __builtin_bit_cast(unsigned, f); return (u + 0x7fffu + ((u >> 16) & 1u)) >> 16; }
__device__ __forceinline__ unsigned pk2(float lo, float hi) { return f2bf(lo) | (f2bf(hi) << 16); }

#define XB_TMO      128
#define XB_XCNT(j)  (256  + 64 * (j))
#define XB_XSUB(j)  (1280 + 64 * (j))
#define XB_XGEN(j)  (2304 + 64 * (j))
#define XB_TOP      3328
#define XB_TOPGEN   3392
#define XCD_BAR_WORDS 3456
#define XB_SPIN_CAP (1u << 22)

__device__ __forceinline__ unsigned xb_ld(unsigned* p)              { return __hip_atomic_load(p, __ATOMIC_RELAXED, __HIP_MEMORY_SCOPE_AGENT); }
__device__ __forceinline__ unsigned xb_add(unsigned* p, unsigned v) { return __hip_atomic_fetch_add(p, v, __ATOMIC_RELAXED, __HIP_MEMORY_SCOPE_AGENT); }
__device__ __forceinline__ unsigned xb_xcc_id() { return (unsigned)__builtin_amdgcn_s_getreg((3 << 11) | 20) & 0xFu; }
#define XB_SPIN(cond, bar) do { unsigned _sp = 0; while (cond) { __builtin_amdgcn_s_sleep(1); \
    if ((++_sp & 255u) == 0u) { if (xb_ld(&(bar)[XB_TMO])) break; if (_sp > XB_SPIN_CAP) { atomicAdd(&(bar)[XB_TMO], 1u); break; } } } } while (0)

struct XcdBarrier {
    unsigned* bar; unsigned x; int w0;
    volatile LAS unsigned* st;
};

__device__ __forceinline__ unsigned xb_lane() { return __builtin_amdgcn_mbcnt_hi(~0u, __builtin_amdgcn_mbcnt_lo(~0u, 0u)); }
__device__ __forceinline__ XcdBarrier xcd_barrier_post(unsigned* bar, volatile LAS unsigned* st, int w0) {
    XcdBarrier b; b.bar = bar; b.x = xb_xcc_id(); b.st = st; b.w0 = w0;
    if (w0 && xb_lane() == 0u) (void)xb_add(&bar[XB_XCNT(b.x)], 1u);
    return b;
}
__device__ __forceinline__ void xcd_barrier_complete(unsigned* bar, unsigned x, unsigned& nloc, unsigned& nx) {
    const unsigned G = gridDim.x * gridDim.y * gridDim.z;
    unsigned sum, cnt, mine, sp = 0u;
    for (;;) {
        sum = 0u; cnt = 0u; mine = 0u;
#pragma unroll
        for (unsigned j = 0; j < 16; ++j) { const unsigned c = xb_ld(&bar[XB_XCNT(j)]); sum += c; cnt += (c > 0u) ? 1u : 0u; mine = (j == x) ? c : mine; }
        if (sum == G) break;
        __builtin_amdgcn_s_sleep(1);
        if ((++sp & 255u) == 0u) { if (xb_ld(&bar[XB_TMO])) break; if (sp > XB_SPIN_CAP) { atomicAdd(&bar[XB_TMO], 1u); break; } }
    }
    nloc = mine > 0u ? mine : 1u; nx = cnt > 0u ? cnt : 1u;
}

__device__ __forceinline__ void xcd_barrier(const XcdBarrier& b) {
    asm volatile("s_waitcnt vmcnt(0)" ::: "memory");
    __syncthreads();
    if (b.w0 && xb_lane() == 0u) {
        unsigned* bar = b.bar;
        __builtin_amdgcn_s_waitcnt(0);
        unsigned nloc = b.st[0], nx = b.st[1];
        if (nloc == 0u) { xcd_barrier_complete(bar, b.x, nloc, nx); b.st[0] = nloc; b.st[1] = nx; }
        const unsigned old = xb_add(&bar[XB_XSUB(b.x)], 1u);
        const unsigned gen = old / nloc;
        if (old + 1u == (gen + 1u) * nloc) {
            __builtin_amdgcn_fence(__ATOMIC_RELEASE, "agent");
            asm volatile("s_waitcnt vmcnt(0)" ::: "memory");
            const unsigned og = xb_add(&bar[XB_TOP], 1u);
            const unsigned tg = og / nx;
            asm volatile("buffer_inv sc1" ::: "memory");
            if (og + 1u == (tg + 1u) * nx) xb_add(&bar[XB_TOPGEN], 1u);
            else XB_SPIN(xb_ld(&bar[XB_TOPGEN]) == tg, bar);
            xb_add(&bar[XB_XGEN(b.x)], 1u);
            asm volatile("s_waitcnt vmcnt(0)" ::: "memory");
        } else {
            asm volatile("buffer_inv sc1" ::: "memory");
            XB_SPIN(xb_ld(&bar[XB_XGEN(b.x)]) == gen, bar);
            asm volatile("s_waitcnt vmcnt(0)" ::: "memory");
        }
    }
    __syncthreads();
}

constexpr int D = 1024, SEQ = 4096, MP = 16384, MS = 512, M = MP + MS;
constexpr int TOKW = 768, MEMW = 256, HG_IN = 3328, SW_IN = 1536, DFF = 2816, NFF1 = 2 * DFF;
constexpr int NWAVES = 8, NTHR = 512;
constexpr float EPS = 1e-6f, LOG2E = 1.4426950408889634f;

constexpr size_t O_Y = 0, O_MK = 17301504, O_MV = 18350080, O_HGP = 19398656, O_HGS = 20185088, O_SKP = 45350912, O_SVP = 45613056, O_SKS = 45875200, O_SVS = 54263808;

constexpr size_t MiB = 1u << 20;
constexpr size_t WS_CTL = 0, CTL_ZERO_BYTES = 1 * MiB;
constexpr size_t WS_SMALL = 1 * MiB;
constexpr size_t WS_WINH = 2 * MiB, WS_WINS = 15 * MiB, WS_WMEM = 21 * MiB, WS_WOUT = 25 * MiB, WS_WFF1 = 33 * MiB, WS_WFF2 = 77 * MiB;
constexpr size_t WS_MEMB = 99 * MiB, WS_MK = 101 * MiB, WS_MV = 103 * MiB;
constexpr size_t WS_X = 105 * MiB, WS_XB = 171 * MiB, WS_ATT = 204 * MiB, WS_CQ = 237 * MiB;
constexpr size_t WS_P = 246 * MiB;
constexpr size_t P_SLAB = (size_t)M * 768 * 2;
constexpr size_t WS_U = 395 * MiB, WS_DD = 491 * MiB, WS_ST = 492 * MiB, WS_END = 540 * MiB;
static_assert(WS_P + 4 * P_SLAB + (size_t)M * 768 * 4 <= WS_U && WS_P + (size_t)M * DFF * 2 <= WS_U && WS_U + (size_t)1536 * 65536 <= WS_DD && WS_ST + (size_t)1536 * 32768 <= WS_END, "ws map");
static_assert(WS_X + (size_t)M * D * 4 <= WS_XB && WS_XB + (size_t)M * D * 2 <= WS_ATT && WS_ATT + (size_t)M * D * 2 <= WS_CQ && WS_CQ + (size_t)M * 256 * 2 <= WS_P, "ws map 2");
constexpr int CW_BAR = 4096;
constexpr int CW_SSQ = 32768;
static_assert((CW_SSQ + 8 * M) * 4 <= (int)CTL_ZERO_BYTES && CW_BAR + XCD_BAR_WORDS <= CW_SSQ, "ctl");

constexpr int RING_BYTES = 131072, MISC_OFF = RING_BYTES + 320, LDS_BYTES = 147456;

typedef float f32x16 __attribute__((ext_vector_type(16)));
typedef short s16x4 __attribute__((ext_vector_type(4)));
typedef float f32x2_t __attribute__((ext_vector_type(2)));
typedef __bf16 bf16x2_t __attribute__((ext_vector_type(2)));
typedef LAS unsigned char* ldsp;
typedef _Float16 lf_t;

__device__ __forceinline__ unsigned cpk(float lo, float hi) { f32x2_t v = {lo, hi}; bf16x2_t b = __builtin_convertvector(v, bf16x2_t); return __builtin_bit_cast(unsigned, b); }
__device__ __forceinline__ v4u cpk8(f32x4 a, f32x4 b) { v4u w; w.x = cpk(a[0], a[1]); w.y = cpk(a[2], a[3]); w.z = cpk(b[0], b[1]); w.w = cpk(b[2], b[3]); return w; }
__device__ __forceinline__ float bf2f(unsigned short x) { return __uint_as_float(((unsigned)x) << 16); }
__device__ __forceinline__ float fexp2(float x) { return __builtin_amdgcn_exp2f(x); }
__device__ __forceinline__ float fsigmoid(float z) { return __builtin_amdgcn_rcpf(1.0f + fexp2(-z * LOG2E)); }
__device__ __forceinline__ float fsilu(float z) { return z * fsigmoid(z); }
constexpr int SSQ_SLABS = 16;
__device__ __forceinline__ float ssq_sum(const float* ssq, int nsl, int row) {
    float s = ssq[row];
    if (nsl > 1) {
        float t[SSQ_SLABS - 1];
#pragma unroll
        for (int k = 1; k < SSQ_SLABS; ++k) t[k - 1] = ssq[(size_t)k * M + row];
#pragma unroll
        for (int k = 1; k < SSQ_SLABS; ++k) s += t[k - 1];
    }
    return s;
}
__device__ __forceinline__ float rms_r(const float* ssq, int row) { return __builtin_amdgcn_rsqf(ssq[row] * (1.0f / 1024.0f) + EPS); }
struct RowScale { float r[2][4]; };
__device__ __forceinline__ RowScale load_row_scales(const float* ssq, int nsl, int row0) {
    RowScale s;
#pragma unroll
    for (int ai = 0; ai < 2; ++ai)
#pragma unroll
        for (int m = 0; m < 4; ++m) s.r[ai][m] = ssq_sum(ssq, nsl, row0 + ai * 128 + m * 16);
#pragma unroll
    for (int ai = 0; ai < 2; ++ai)
#pragma unroll
        for (int m = 0; m < 4; ++m) s.r[ai][m] = __builtin_amdgcn_rsqf(s.r[ai][m] * (1.0f / 1024.0f) + EPS);
    asm volatile("" ::: "memory");
    return s;
}
template <bool ALL_FROM_TAB = false>
__device__ __forceinline__ RowScale get_row_scales(const float* ssq, int nsl, const pg8::Unit& u, int row0, int ui, const LAS float* tab, int wr, int fr) {
    if (!ALL_FROM_TAB && u.pm >= 64) return load_row_scales(ssq, nsl, row0);
    RowScale s;
#pragma unroll
    for (int ai = 0; ai < 2; ++ai)
#pragma unroll
        for (int m = 0; m < 4; ++m) s.r[ai][m] = tab[ui * 256 + wr * 64 + fr + ai * 128 + m * 16];
    return s;
}
__device__ __forceinline__ float wave_sum(float v) {
#pragma unroll
    for (int o = 1; o < 64; o <<= 1) v += __shfl_xor(v, o);
    return v;
}
#define MFMA32(a, b, c) __builtin_amdgcn_mfma_f32_32x32x16_bf16((a), (b), (c), 0, 0, 0)
#define MFMA16(a, b, c) __builtin_amdgcn_mfma_f32_16x16x32_bf16((a), (b), (c), 0, 0, 0)
__device__ __forceinline__ s16x4 ldtr(LAS const unsigned char* p) { return __builtin_bit_cast(s16x4, __builtin_amdgcn_ds_read_tr16_b64_v4i16((LAS s16x4*)p)); }
__device__ __forceinline__ bf16x8 cat8(s16x4 lo, s16x4 hi) { return __builtin_shufflevector(lo, hi, 0, 1, 2, 3, 4, 5, 6, 7); }

using pg8::Unit;

struct EpiHG {
    static constexpr bool PERM = true, AFTER_DRAIN = false, USE_TAB = true;
    __device__ __forceinline__ float row_scale(const Unit& u, int row) const { return __builtin_amdgcn_rsqf(ssq_sum(ssq, nsl, u.pm * 256 + row) * (1.0f / 1024.0f) + EPS); }
    const float* ssq; int nsl; const float* pt;
    unsigned char* P; bf16* CQ;
    __device__ __forceinline__ void operator()(const f32x4 (&acc)[2][2][4][2], const Unit& u, int wr, int wc, int fr, int fq, int ui, const LAS float* tab) const {
        const int row0 = u.pm * 256 + wr * 64 + fr, pn = u.pn;
        const RowScale RS = get_row_scales<true>(ssq, nsl, u, row0, ui, tab, wr, fr);
        if (pn >= 12) {
            f32x4 g[2][2];
#pragma unroll
            for (int bj = 0; bj < 2; ++bj)
#pragma unroll
                for (int n = 0; n < 2; ++n) g[bj][n] = *(const f32x4*)(pt + 1536 + 32 * bj + 8 * fq + 4 * n);
#pragma unroll
            for (int ai = 0; ai < 2; ++ai)
#pragma unroll
                for (int m = 0; m < 4; ++m) {
                    const int row = row0 + ai * 128 + m * 16; const float r = RS.r[ai][m];
                    f32x4 v[2][2]; float ss = 0.f;
#pragma unroll
                    for (int bj = 0; bj < 2; ++bj)
#pragma unroll
                        for (int n = 0; n < 2; ++n) { v[bj][n] = acc[ai][bj][m][n] * r; const f32x4 q = v[bj][n] * v[bj][n]; ss += (q[0] + q[1]) + (q[2] + q[3]); }
                    ss += __shfl_xor(ss, 16); ss += __shfl_xor(ss, 32);
                    const float rs = __builtin_amdgcn_rsqf(ss * (1.0f / 64.0f) + EPS);
#pragma unroll
                    for (int bj = 0; bj < 2; ++bj)
                        *(v4u*)(CQ + (size_t)row * 256 + wc * 64 + 32 * bj + 8 * fq) = cpk8(v[bj][0] * rs * g[bj][0], v[bj][1] * rs * g[bj][1]);
                }
            return;
        }
        const int typ = pn / 3, cb = (pn % 3) * 256 + wc * 32 + 8 * fq;
        bf16* const slab = (bf16*)(P + (size_t)typ * P_SLAB);
        lf_t* const LFp = (lf_t*)(P + 4 * P_SLAB);
        f32x4 pa[2][2];
#pragma unroll
        for (int bj = 0; bj < 2; ++bj)
#pragma unroll
            for (int n = 0; n < 2; ++n) pa[bj][n] = *(const f32x4*)(pt + (typ == 3 ? 768 : 0) + cb + bj * 128 + 4 * n);
#pragma unroll
        for (int ai = 0; ai < 2; ++ai)
#pragma unroll
            for (int m = 0; m < 4; ++m) {
                const int row = row0 + ai * 128 + m * 16; const float r = RS.r[ai][m];
#pragma unroll
                for (int bj = 0; bj < 2; ++bj) {
                    const size_t off = (size_t)row * 768 + cb + bj * 128;
                    f32x4 v[2] = {acc[ai][bj][m][0] * r, acc[ai][bj][m][1] * r};
                    if (typ == 0) {
#pragma unroll
                        for (int n = 0; n < 2; ++n)
#pragma unroll
                            for (int e = 0; e < 4; ++e) v[n][e] = fsilu(v[n][e]) * 0.08838834764831845f;
                    } else if (typ == 1) {
                        typedef _Float16 h2_t __attribute__((ext_vector_type(2))); v4u hw;
                        hw.x = __builtin_bit_cast(unsigned, (h2_t){(_Float16)v[0][0], (_Float16)v[0][1]}); hw.y = __builtin_bit_cast(unsigned, (h2_t){(_Float16)v[0][2], (_Float16)v[0][3]});
                        hw.z = __builtin_bit_cast(unsigned, (h2_t){(_Float16)v[1][0], (_Float16)v[1][1]}); hw.w = __builtin_bit_cast(unsigned, (h2_t){(_Float16)v[1][2], (_Float16)v[1][3]});
                        *(v4u*)(LFp + off) = hw;
                        continue;
                    } else if (typ == 3) {
#pragma unroll
                        for (int n = 0; n < 2; ++n)
#pragma unroll
                            for (int e = 0; e < 4; ++e) v[n][e] = fsilu(v[n][e]) * pa[bj][n][e];
                    }
                    *(v4u*)(slab + off) = cpk8(v[0], v[1]);
                }
            }
    }
};

struct EpiSW {
    static constexpr bool PERM = true, AFTER_DRAIN = false, USE_TAB = true;
    __device__ __forceinline__ float row_scale(const Unit& u, int row) const { return __builtin_amdgcn_rsqf(ssq_sum(ssq, nsl, u.pm * 256 + row) * (1.0f / 1024.0f) + EPS); }
    const float* ssq; int nsl; const float* gt;
    unsigned char* ws; float* out; int j;
    __device__ __forceinline__ void operator()(const f32x4 (&acc)[2][2][4][2], const Unit& u, int wr, int wc, int fr, int fq, int ui, const LAS float* tab) const {
        const int row0 = u.pm * 256 + wr * 64 + fr, pn = u.pn;
        const RowScale RS = get_row_scales<true>(ssq, nsl, u, row0, ui, tab, wr, fr);
        const int gi = pn < 3 ? 0 : pn - 2;
        f32x4 g[2][2];
#pragma unroll
        for (int bj = 0; bj < 2; ++bj)
#pragma unroll
            for (int n = 0; n < 2; ++n) g[bj][n] = *(const f32x4*)(gt + gi * 64 + 32 * bj + 8 * fq + 4 * n);
        bf16* const ob = (bf16*)(ws + (pn < 5 ? WS_P + (size_t)pn * 512 : WS_CQ)); const int opitch = pn < 5 ? 1280 : 256;
#pragma unroll
        for (int ai = 0; ai < 2; ++ai)
#pragma unroll
            for (int m = 0; m < 4; ++m) {
                const int row = row0 + ai * 128 + m * 16; const float r = RS.r[ai][m];
                f32x4 v[2][2]; float ss = 0.f;
#pragma unroll
                for (int bj = 0; bj < 2; ++bj)
#pragma unroll
                    for (int n = 0; n < 2; ++n) { v[bj][n] = acc[ai][bj][m][n] * r; const f32x4 q = v[bj][n] * v[bj][n]; ss += (q[0] + q[1]) + (q[2] + q[3]); }
                ss += __shfl_xor(ss, 16); ss += __shfl_xor(ss, 32);
                const float rs = (pn == 4) ? 1.0f : __builtin_amdgcn_rsqf(ss * (1.0f / 64.0f) + EPS);
                long doff = -1;
                if (pn == 3 || pn == 4) {
                    if (row < MP) { const int t = row & 4095; if (t >= 3968) doff = (long)(pn == 3 ? O_SKP : O_SVP) + (long)j * (4 * 128 * 256) + ((long)((row >> 12) * 128 + (t - 3968)) * 4 + wc) * 64; }
                    else { const int idx = row - MP; doff = (long)(pn == 3 ? O_SKS : O_SVS) + (long)j * (128 * 128 * 256) + ((long)((idx >> 2) * 128 + 124 + (idx & 3)) * 4 + wc) * 64; }
                }
#pragma unroll
                for (int bj = 0; bj < 2; ++bj) {
                    const f32x4 o0 = v[bj][0] * rs * g[bj][0], o1 = v[bj][1] * rs * g[bj][1];
                    *(v4u*)(ob + (size_t)row * opitch + wc * 64 + 32 * bj + 8 * fq) = cpk8(o0, o1);
                    if (doff >= 0) { float* dst = out + doff + 32 * bj + 8 * fq; *(f32x4*)dst = o0; *(f32x4*)(dst + 4) = o1; }
                }
            }
    }
};

struct EpiMem {
    static constexpr bool PERM = true, AFTER_DRAIN = false, USE_TAB = true;
    __device__ __forceinline__ float row_scale(const Unit& u, int row) const { return (u.pm >= 64) ? 0.f : __builtin_amdgcn_rsqf(ssq_sum(ssq, nsl, u.pm * 256 + row) * (1.0f / 1024.0f) + EPS); }
    const float* ssq; int nsl; const float* kn; bf16* MK; float* ok;
    __device__ __forceinline__ void operator()(const f32x4 (&acc)[2][2][4][2], const Unit& u, int wr, int wc, int fr, int fq, int ui, const LAS float* tab) const {
        const int row0 = u.pm * 256 + wr * 64 + fr, layer = u.pn >> 1; const bool isv = (u.pn & 1) != 0;
        const RowScale RS = get_row_scales(ssq, nsl, u, row0, ui, tab, wr, fr);
        f32x4 g[2][2];
#pragma unroll
        for (int bj = 0; bj < 2; ++bj)
#pragma unroll
            for (int n = 0; n < 2; ++n) { const f32x4 gl = *(const f32x4*)(kn + layer * 64 + 32 * bj + 8 * fq + 4 * n); g[bj][n] = isv ? (f32x4){1.f, 1.f, 1.f, 1.f} : gl; }
#pragma unroll
        for (int ai = 0; ai < 2; ++ai)
#pragma unroll
            for (int m = 0; m < 4; ++m) {
                const int row = row0 + ai * 128 + m * 16; const float r = RS.r[ai][m];
                f32x4 v[2][2]; float ss = 0.f;
#pragma unroll
                for (int bj = 0; bj < 2; ++bj)
#pragma unroll
                    for (int n = 0; n < 2; ++n) { v[bj][n] = acc[ai][bj][m][n] * r; const f32x4 q = v[bj][n] * v[bj][n]; ss += (q[0] + q[1]) + (q[2] + q[3]); }
                ss += __shfl_xor(ss, 16); ss += __shfl_xor(ss, 32);
                const float rs = isv ? 1.0f : __builtin_amdgcn_rsqf(ss * (1.0f / 64.0f) + EPS);
                const size_t off = (isv ? (size_t)1048576 : (size_t)0) + ((size_t)layer * 1024 + row) * 256 + wc * 64 + 8 * fq;
#pragma unroll
                for (int bj = 0; bj < 2; ++bj) {
                    const f32x4 o0 = v[bj][0] * rs * g[bj][0], o1 = v[bj][1] * rs * g[bj][1];
                    *(v4u*)(MK + off + 32 * bj) = cpk8(o0, o1);
                    float* dst = ok + off + 32 * bj;
                    *(f32x4*)dst = o0; *(f32x4*)(dst + 4) = o1;
                }
            }
    }
};

struct EpiFF1 {
    static constexpr bool PERM = true, AFTER_DRAIN = false, USE_TAB = true;
    __device__ __forceinline__ float row_scale(const Unit& u, int row) const { return (u.pm >= 64) ? 0.f : __builtin_amdgcn_rsqf(ssq_sum(ssq, nsl, u.pm * 256 + row) * (1.0f / 1024.0f) + EPS); }
    const float* ssq; int nsl; bf16* ACT;
    __device__ __forceinline__ void operator()(const f32x4 (&acc)[2][2][4][2], const Unit& u, int wr, int wc, int fr, int fq, int ui, const LAS float* tab) const {
        const int row0 = u.pm * 256 + wr * 64 + fr;
        const RowScale RS = get_row_scales(ssq, nsl, u, row0, ui, tab, wr, fr);
#pragma unroll
        for (int ai = 0; ai < 2; ++ai)
#pragma unroll
            for (int m = 0; m < 4; ++m) {
                const int row = row0 + ai * 128 + m * 16; const float r = RS.r[ai][m];
                f32x4 a[2];
#pragma unroll
                for (int n = 0; n < 2; ++n)
#pragma unroll
                    for (int e = 0; e < 4; ++e) a[n][e] = fsilu(acc[ai][0][m][n][e] * r) * (acc[ai][1][m][n][e] * r);
                *(v4u*)(ACT + (size_t)row * DFF + u.pn * 128 + wc * 32 + 8 * fq) = cpk8(a[0], a[1]);
            }
    }
};

struct EpiRes {
    static constexpr bool PERM = true, AFTER_DRAIN = false, USE_TAB = false;
    bf16* XB; float* yout; float* ssq_out;
    __device__ __forceinline__ void operator()(const f32x4 (&acc)[2][2][4][2], const Unit& u, int wr, int wc, int fr, int fq, int ui, const LAS float* tab) const {
        const int row0 = u.pm * 256 + wr * 64 + fr, col0 = u.pn * 256 + wc * 32 + 8 * fq;
#pragma unroll
        for (int ai = 0; ai < 2; ++ai) {
            v4u res[4][2];
#pragma unroll
            for (int m = 0; m < 4; ++m)
#pragma unroll
                for (int bj = 0; bj < 2; ++bj) res[m][bj] = *(const v4u*)(XB + (size_t)(row0 + ai * 128 + m * 16) * D + col0 + bj * 128);
            asm volatile("" ::: "memory");
#pragma unroll
            for (int m = 0; m < 4; ++m) {
                const int row = row0 + ai * 128 + m * 16; float s = 0.f;
#pragma unroll
                for (int bj = 0; bj < 2; ++bj) {
                    const size_t off = (size_t)row * D + col0 + bj * 128;
                    const v4u w = res[m][bj];
                    const f32x4 b0 = {__uint_as_float(w.x << 16), __uint_as_float(w.x & 0xffff0000u), __uint_as_float(w.y << 16), __uint_as_float(w.y & 0xffff0000u)};
                    const f32x4 b1 = {__uint_as_float(w.z << 16), __uint_as_float(w.z & 0xffff0000u), __uint_as_float(w.w << 16), __uint_as_float(w.w & 0xffff0000u)};
                    const f32x4 x0 = b0 + acc[ai][bj][m][0], x1 = b1 + acc[ai][bj][m][1];
                    if (yout) { *(f32x4*)(yout + off) = x0; *(f32x4*)(yout + off + 4) = x1; }
                    else {
                        const v4u o = cpk8(x0, x1);
                        *(v4u*)(XB + off) = o;
                        const f32x4 r0 = {__uint_as_float(o.x << 16), __uint_as_float(o.x & 0xffff0000u), __uint_as_float(o.y << 16), __uint_as_float(o.y & 0xffff0000u)};
                        const f32x4 r1 = {__uint_as_float(o.z << 16), __uint_as_float(o.z & 0xffff0000u), __uint_as_float(o.w << 16), __uint_as_float(o.w & 0xffff0000u)};
                        const f32x4 q0 = r0 * r0, q1 = r1 * r1; s += ((q0[0] + q0[1]) + (q0[2] + q0[3])) + ((q1[0] + q1[1]) + (q1[2] + q1[3]));
                    }
                }
                if (!yout) {
                    s += __shfl_xor(s, 16); s += __shfl_xor(s, 32);
                    if (fq == 0) ssq_out[(size_t)((u.pn & 3) * 4 + wc) * M + row] = s;
                }
            }
            asm volatile("" ::: "memory");
        }
    }
};

struct TrItem { const float* W; const float* gain; bf16* WT; int K, N, dst_row0, k0, n0; };
constexpr int TRSTR = 72;
__device__ __forceinline__ void tr_load(const TrItem& t, f32x4 (&v)[8], int lane) {
#pragma unroll
    for (int i = 0; i < 8; ++i) { const int kk = 8 * i + (lane >> 3); const float gk = t.gain ? t.gain[t.k0 + kk] : 1.0f; v[i] = __builtin_nontemporal_load((const f32x4*)(t.W + (size_t)(t.k0 + kk) * t.N + t.n0 + 4 * (lane & 7))) * gk; }
}
__device__ __forceinline__ void tr_store(const TrItem& t, const f32x4 (&v)[8], ldsp scr, int lane) {
#pragma unroll
    for (int i = 0; i < 8; ++i) { const int kk = 8 * i + (lane >> 3);
        *(LAS unsigned long long*)(scr + kk * TRSTR + 8 * (lane & 7)) = (unsigned long long)cpk(v[i][0], v[i][1]) | ((unsigned long long)cpk(v[i][2], v[i][3]) << 32); }
    const int i16 = lane & 15, g = lane >> 4, n = 16 * (g >> 1) + i16;
#pragma unroll
    for (int p = 0; p < 4; ++p) {
        const int kc = 2 * p + (g & 1);
        LAS const unsigned char* a = scr + (8 * kc + (i16 >> 2)) * TRSTR + (16 * (g >> 1) + 4 * (i16 & 3)) * 2;
        const bf16x8 o = cat8(ldtr(a), ldtr(a + 4 * TRSTR));
        *(bf16x8*)(t.WT + (size_t)(t.dst_row0 + n) * t.K + t.k0 + 8 * kc) = o;
    }
    LDS_WAIT(); asm volatile("" ::: "memory");
}
__device__ __forceinline__ int head_row0(int n0) { return (n0 & ~255) + 128 * ((n0 >> 5) & 1) + 32 * ((n0 >> 6) & 3); }
__device__ __forceinline__ float row_to_bf16(const float* xrow, bf16* orow, int lane) {
    const f32x4* xr = (const f32x4*)xrow + lane; float s = 0.f;
    unsigned long long* o8 = (unsigned long long*)orow + lane;
#pragma unroll
    for (int j = 0; j < 4; ++j) { const f32x4 v = xr[64 * j]; s += (v[0] * v[0] + v[1] * v[1]) + (v[2] * v[2] + v[3] * v[3]);
        o8[64 * j] = (unsigned long long)cpk(v[0], v[1]) | ((unsigned long long)cpk(v[2], v[3]) << 32); }
    return wave_sum(s);
}


constexpr int CW_CNT = 24576;
__device__ __forceinline__ void publish_tile(unsigned* cnt) {
    asm volatile("s_waitcnt vmcnt(0)" ::: "memory");
    if (xb_lane() == 0u) {
        LAS unsigned* wc = (LAS unsigned*)(unsigned)(MISC_OFF + 48);
        const unsigned old = __hip_atomic_fetch_add(wc, 1u, __ATOMIC_RELAXED, __HIP_MEMORY_SCOPE_WORKGROUP);
        if (old == 7u) {
            __hip_atomic_store(wc, 0u, __ATOMIC_RELAXED, __HIP_MEMORY_SCOPE_WORKGROUP);
            __builtin_amdgcn_fence(__ATOMIC_RELEASE, "agent");
            asm volatile("s_waitcnt vmcnt(0)" ::: "memory");
            (void)__hip_atomic_fetch_add(cnt, 8u, __ATOMIC_RELAXED, __HIP_MEMORY_SCOPE_AGENT);
        }
    }
}
#ifndef G3_SWAP
#define G3_SWAP 1
#endif
struct OrderG3 {
    pg8::StaticOrder so; int c; bool rebal; unsigned* cnt; bool swa; unsigned* cntA; int w0;
    __device__ __forceinline__ bool next(int i, Unit& u) const {
        if (!rebal) return so.next(i, u);
        if (c < 128) return i <= 5 ? so.tile((long)i * 256 + c, u) : false;
        if (c < 152) { if (i <= 4) return so.tile((long)i * 256 + c, u); if (i == 5) { const int o = c - 128; return so.tile((long)(2 + (o >> 3)) * 256 + 248 + (o & 7), u); } return false; }
        if (c < 196) { const int is = swa ? 1 : 0;
            if (i == is) { const int t = c - 152; u.pm = 64 + t / 22; u.pn = t % 22; return true; }
            return i <= (G3_SWAP ? 4 : 5) ? so.tile((long)(i < is ? i : i - 1) * 256 + c, u) : false; }
        if (c < 248) { if (i <= 4) return so.tile((long)i * 256 + c, u); if (swa && i == 5 && c < 204) return so.tile((long)256 + 248 + (c - 196), u); if (G3_SWAP && i == 5 && c >= 204) return so.tile((long)4 * 256 + (c < 244 ? c - 48 : 152 + (c - 244)), u); return false; }
        return i <= (swa ? 0 : 1) ? so.tile((long)i * 256 + c, u) : false;
    }
    __device__ __forceinline__ void a_ready(const Unit& u) const {
        if (rebal && swa && u.pm >= 64) {
            if (w0) {
                unsigned sp = 0;
                while ((unsigned)__builtin_amdgcn_readfirstlane(__hip_atomic_load(cntA + 64 * (u.pm - 64), __ATOMIC_RELAXED, __HIP_MEMORY_SCOPE_AGENT)) < 32u) { __builtin_amdgcn_s_sleep(2); if (++sp > (1u << 22)) break; }
                __builtin_amdgcn_fence(__ATOMIC_ACQUIRE, "agent");
                asm volatile("s_waitcnt vmcnt(0)" ::: "memory");
            }
            asm volatile("" ::: "memory"); __builtin_amdgcn_s_barrier(); asm volatile("" ::: "memory");
        }
    }
    __device__ __forceinline__ void done(const Unit& u) const {
        if (rebal && u.pm >= 64) publish_tile(cnt + 64 * (u.pm - 64));
    }
};
struct OneUnit {
    int pm, pn; unsigned* cnt;
    __device__ __forceinline__ bool next(int i, Unit& u) const { if (i != 0) return false; u.pm = pm; u.pn = pn; return true; }
    __device__ __forceinline__ void a_ready(const Unit&) const {}
    __device__ __forceinline__ void done(const Unit&) const {
        if (cnt) publish_tile(cnt);
    }
};

#define LAUNDER_S(x) asm volatile("" : "+s"(x))
#define INP(k) ({ int k_ = (k); LAUNDER_S(k_); (const float*)(const GAS float*)a.in[k_]; })
struct Args { const float* in[24]; float* out; unsigned char* ws; int ph_lo, ph_hi, use_bar, pad; };

struct Ctx {
    ldsp lds; int tid, lane, wid, G, bid;
    const float* const* in; float* out; unsigned char* ws;
};

__device__ __forceinline__ int layer_items(int L) { return ((L & 1) ? 768 : 1664) + 512 + 2816 + 1408; }
__device__ __forceinline__ TrItem layer_item(const Args& a, unsigned char* ws, int L, int it) {
    TrItem t; int r = it; const int j = L >> 1;
    if ((L & 1) == 0) {
        if (r < 1664) { const int kb = r / 104, nb = r % 104, n0 = nb * 32;
            t.W = INP(11) + (size_t)j * D * HG_IN; t.K = D; t.N = HG_IN; t.gain = INP(8) + L * D; t.WT = (bf16*)(ws + WS_WINH) + (size_t)j * HG_IN * D; t.dst_row0 = n0 < 3072 ? n0 : head_row0(n0); t.k0 = kb * 64; t.n0 = n0; return t; }
        r -= 1664;
    } else {
        if (r < 768) { const int kb = r / 48, nb = r % 48, n0 = nb * 32;
            t.W = INP(14) + (size_t)j * D * SW_IN; t.K = D; t.N = SW_IN; t.gain = INP(8) + L * D; t.WT = (bf16*)(ws + WS_WINS) + (size_t)j * SW_IN * D; t.dst_row0 = head_row0(n0); t.k0 = kb * 64; t.n0 = n0; return t; }
        r -= 768;
    }
    if (r < 512) { const int kb = r / 32, nb = r % 32, n0 = nb * 32;
        t.W = INP(21) + (size_t)L * D * D; t.K = D; t.N = D; t.gain = nullptr; t.WT = (bf16*)(ws + WS_WOUT) + (size_t)L * D * D; t.dst_row0 = n0; t.k0 = kb * 64; t.n0 = n0; return t; } r -= 512;
    if (r < 2816) { const int kb = r / 176, nb = r % 176, n0 = nb * 32; const int jj = n0 < DFF ? n0 : n0 - DFF;
        t.W = INP(22) + (size_t)L * D * NFF1; t.K = D; t.N = NFF1; t.gain = INP(9) + L * D; t.WT = (bf16*)(ws + WS_WFF1) + (size_t)L * NFF1 * D; t.dst_row0 = 256 * (jj >> 7) + (n0 < DFF ? 0 : 128) + (jj & 127); t.k0 = kb * 64; t.n0 = n0; return t; } r -= 2816;
    { const int kb = r / 32, nb = r % 32, n0 = nb * 32;
        t.W = INP(23) + (size_t)L * DFF * D; t.K = DFF; t.N = D; t.gain = nullptr; t.WT = (bf16*)(ws + WS_WFF2) + (size_t)L * D * DFF; t.dst_row0 = n0; t.k0 = kb * 64; t.n0 = n0; return t; }
}
__device__ __forceinline__ TrItem mem_item(const Args& a, unsigned char* ws, int r) {
    TrItem t; const int i = r / 256, q = r % 256, kb = q / 16, nb = q % 16, n0 = nb * 32;
    t.W = INP(18) + (size_t)i * D * 512; t.K = D; t.N = 512; t.gain = INP(10) + i * D; t.WT = (bf16*)(ws + WS_WMEM); t.dst_row0 = 512 * i + head_row0(n0); t.k0 = kb * 64; t.n0 = n0; return t;
}
__device__ __forceinline__ void convert_weights(const Args& a, unsigned char* ws, ldsp lds, int L, int lo, int hi, bool with_mem, int wv, int nwv, int wid, int lane) {
    ldsp scr = lds + wid * 8192;
    const int nl = hi - lo, ntot = nl + (with_mem ? 1024 : 0);
    f32x4 v[8]; TrItem cur;
    if (wv < ntot) { cur = wv < nl ? layer_item(a, ws, L, lo + wv) : mem_item(a, ws, wv - nl); tr_load(cur, v, lane); }
#pragma unroll 1
    for (int it = wv; it < ntot; it += nwv) {
        f32x4 w[8];
#pragma unroll
        for (int i = 0; i < 8; ++i) w[i] = v[i];
        const TrItem me = cur; const int nx = it + nwv;
        if (nx < ntot) { cur = nx < nl ? layer_item(a, ws, L, lo + nx) : mem_item(a, ws, nx - nl); tr_load(cur, v, lane); }
        tr_store(me, w, scr, lane);
    }
}
__device__ __forceinline__ void phase_prologue(const Args& a, ldsp lds, int tid, int lane, int wid, int bid, int G) {
    GAS unsigned char* wsg_ = (GAS unsigned char*)a.ws; LAUNDER_S(wsg_); unsigned char* ws = (unsigned char*)wsg_;
    const int gw = bid * NWAVES + wid, NGW = G * NWAVES;
    convert_weights(a, ws, lds, 0, 0, layer_items(0), true, gw, NGW, wid, lane);
    float* ssq0 = (float*)(ws + WS_CTL) + CW_SSQ;
    {
        const float* x0 = INP(0); const float* x1 = INP(1);
#pragma unroll 1
        for (int m = gw; m < M; m += 3 * NGW) {
            f32x4 v[3][4]; int mm[3];
#pragma unroll
            for (int k = 0; k < 3; ++k) {
                mm[k] = m + k * NGW; const int mc = mm[k] < M ? mm[k] : m;
                const f32x4* xr = (const f32x4*)(mc < MP ? x0 + (size_t)mc * D : x1 + (size_t)(mc - MP) * D) + lane;
#pragma unroll
                for (int j = 0; j < 4; ++j) v[k][j] = __builtin_nontemporal_load(&xr[64 * j]);
            }
#pragma unroll
            for (int k = 0; k < 3; ++k) {
                float s = 0.f;
                unsigned long long* o8 = (unsigned long long*)((bf16*)(ws + WS_XB) + (size_t)(mm[k] < M ? mm[k] : m) * D) + lane;
                if (mm[k] < M) {
#pragma unroll
                    for (int j = 0; j < 4; ++j) { const f32x4 w = v[k][j]; s += (w[0] * w[0] + w[1] * w[1]) + (w[2] * w[2] + w[3] * w[3]);
                        o8[64 * j] = (unsigned long long)cpk(w[0], w[1]) | ((unsigned long long)cpk(w[2], w[3]) << 32); }
                }
                s = wave_sum(s);
                if (lane == 0 && mm[k] < M) ssq0[mm[k]] = s;
            }
        }
    }
    float* ssqm = (float*)(ws + WS_SMALL + 16384);
    for (int m = gw; m < 1024; m += NGW) {
        const float s = row_to_bf16(INP(7) + (size_t)m * D, (bf16*)(ws + WS_MEMB) + (size_t)m * D, lane);
        if (lane == 0) ssqm[m] = s;
    }
    if (bid == 0) {
        float* pt = (float*)(ws + WS_SMALL);
        for (int c = tid; c < TOKW; c += NTHR) {
            const float r0 = INP(12)[c], r1 = INP(12)[TOKW + c], mx = fmaxf(r0, r1), e0 = __expf(r0 - mx), e1 = __expf(r1 - mx), sm1 = e1 / (e0 + e1);
            pt[c] = 0.0f; pt[2048 + c] = fminf(fmaxf(sm1, 0.0f), 0.999f);
            pt[768 + c] = INP(13)[c]; pt[2048 + 768 + c] = INP(13)[TOKW + c];
        }
        if (tid < 64) { pt[1536 + tid] = INP(19)[tid]; pt[2048 + 1536 + tid] = INP(19)[128 + tid]; }
        float* gt = (float*)(ws + WS_SMALL + 32768);
        if (tid < 128) { const int j = tid >> 6, d = tid & 63; gt[j * 256 + d] = INP(15)[j * 64 + d]; gt[j * 256 + 64 + d] = INP(16)[j * 64 + d]; gt[j * 256 + 128 + d] = 1.0f; gt[j * 256 + 192 + d] = INP(19)[(2 * j + 1) * 64 + d]; }
    }
}

constexpr int KSTR = 144;
template <int NROWS>
__device__ __forceinline__ void stage_bf16_rows2(ldsp dk, ldsp dv, const bf16* sk, const bf16* sv, long pitch, int row_lo, int tid) {
    constexpr int NIT = NROWS * 8 / NTHR;
    v4u a[NIT], b[NIT];
#pragma unroll
    for (int k = 0; k < NIT; ++k) { const int idx = tid + NTHR * k, row = idx >> 3, ch = idx & 7; const long rr = max(row_lo + row, 0);
        a[k] = *(const v4u*)(sk + rr * pitch + ch * 8); b[k] = *(const v4u*)(sv + rr * pitch + ch * 8); }
#pragma unroll
    for (int k = 0; k < NIT; ++k) { const int idx = tid + NTHR * k, row = idx >> 3, ch = idx & 7; const bool z = row_lo + row < 0;
        *(LAS v4u*)(dk + row * KSTR + ch * 16) = z ? (v4u){0u, 0u, 0u, 0u} : a[k]; *(LAS v4u*)(dv + row * KSTR + ch * 16) = z ? (v4u){0u, 0u, 0u, 0u} : b[k]; }
}
struct AttnP { unsigned char* ws; const bf16* MK; const float* cmk; const float* cmv; const float* csk; const float* csv; const float* sinks; float* oks; };
__device__ __forceinline__ void sample_attn_unit(int typ, int u, const AttnP& P, ldsp lds, int tid, int lane, int wid) {
    const int r = lane & 31, h = lane >> 5, i16 = lane & 15, g4 = lane >> 4, b = u >> 2, hx = u & 3;
    const bf16* const QKVp = (const bf16*)(P.ws + WS_P); bf16* const ATTp = (bf16*)(P.ws + WS_ATT);
    ldsp Vw = lds + wid * (32 * KSTR);
    LAS float* cm = (LAS float*)(lds + 8 * 32 * KSTR);
    LAS float* cl = cm + 128;
    LAS float* co = cl + 128;
    const int nw = typ == 1 ? 5 : 8, nq = typ == 1 ? 12 : 4;
    const float sc = 0.125f * LOG2E;
    if (wid < nw) {
        const int rr = r < nq ? r : 0;
        size_t qoff;
        if (typ == 1) qoff = ((size_t)MP + 4 * b + (rr & 3)) * 1280 + (hx * 3 + (rr >> 2)) * 64;
        else qoff = ((size_t)MP + 4 * b + rr) * 256 + hx * 64;
        const bf16* qsrc = (const bf16*)(P.ws + (typ == 1 ? WS_P : WS_CQ));
        bf16x8 qf[4];
#pragma unroll
        for (int d0 = 0; d0 < 4; ++d0) qf[d0] = *(const bf16x8*)(qsrc + qoff + d0 * 16 + h * 8);
        bf16x8 kf[4];
        const bool newrows = (typ == 1 && wid == 4);
        if (!newrows) {
            const float* kb; const float* vbp; int pitch;
            if (typ == 1) { kb = P.csk + ((size_t)b * 128 + 32 * wid) * 256 + hx * 64; vbp = P.csv + ((size_t)b * 128 + 32 * wid) * 256 + hx * 64; pitch = 256; }
            else { kb = P.cmk + ((size_t)b * 256 + 32 * wid) * 256 + hx * 64; vbp = P.cmv + ((size_t)b * 256 + 32 * wid) * 256 + hx * 64; pitch = 256; }
            f32x4 ka[4][2], va[8];
#pragma unroll
            for (int d0 = 0; d0 < 4; ++d0) { const float* p = kb + (size_t)r * pitch + d0 * 16 + h * 8; ka[d0][0] = *(const f32x4*)p; ka[d0][1] = *(const f32x4*)(p + 4); }
#pragma unroll
            for (int k = 0; k < 8; ++k) { const int idx = lane + 64 * k, row = idx >> 4, ch = idx & 15; va[k] = __builtin_nontemporal_load((const f32x4*)(vbp + (size_t)row * pitch + ch * 4)); }
#pragma unroll
            for (int d0 = 0; d0 < 4; ++d0) kf[d0] = __builtin_bit_cast(bf16x8, cpk8(ka[d0][0], ka[d0][1]));
#pragma unroll
            for (int k = 0; k < 8; ++k) { const int idx = lane + 64 * k, row = idx >> 4, ch = idx & 15;
                *(LAS unsigned long long*)(Vw + row * KSTR + ch * 8) = (unsigned long long)cpk(va[k][0], va[k][1]) | ((unsigned long long)cpk(va[k][2], va[k][3]) << 32); }
            if (typ == 1) {
                float* ok = P.oks + (size_t)b * 128 * 256 + hx * 64; float* ov = ok + (O_SVS - O_SKS);
                const int krow = 32 * wid + r;
                if (krow >= 4) {
#pragma unroll
                    for (int d0 = 0; d0 < 4; ++d0) { float* p = ok + (size_t)(krow - 4) * 256 + d0 * 16 + h * 8; *(f32x4*)p = ka[d0][0]; *(f32x4*)(p + 4) = ka[d0][1]; }
                }
#pragma unroll
                for (int k = 0; k < 8; ++k) { const int idx = lane + 64 * k, row = 32 * wid + (idx >> 4), ch = idx & 15; if (row >= 4) __builtin_nontemporal_store(va[k], (f32x4*)(ov + (size_t)(row - 4) * 256 + ch * 4)); }
            }
        } else {
            const bf16* src = QKVp + ((size_t)MP + 4 * b + (r & 3)) * 1280 + 768 + hx * 64;
#pragma unroll
            for (int d0 = 0; d0 < 4; ++d0) { const bf16x8 t8 = *(const bf16x8*)(src + d0 * 16 + h * 8); kf[d0] = r < 4 ? t8 : (bf16x8){0, 0, 0, 0, 0, 0, 0, 0}; }
#pragma unroll
            for (int k = 0; k < 4; ++k) { const int idx = lane + 64 * k, row = idx >> 3, ch = idx & 7;
                v4u vv = {0u, 0u, 0u, 0u}; if (row < 4) vv = *(const v4u*)(QKVp + ((size_t)MP + 4 * b + row) * 1280 + 1024 + hx * 64 + ch * 8);
                *(LAS v4u*)(Vw + row * KSTR + ch * 16) = vv; }
        }
        f32x16 s;
#pragma unroll
        for (int e = 0; e < 16; ++e) s[e] = 0.f;
#pragma unroll
        for (int d0 = 0; d0 < 4; ++d0) s = MFMA32(kf[d0], qf[d0], s);
        const int tq = rr & 3;
        float mx = -1e30f;
#pragma unroll
        for (int e = 0; e < 16; ++e) { const int kidx = 32 * wid + (e & 3) + 8 * (e >> 2) + 4 * h; const bool ok = (typ != 1) || (kidx > tq && kidx <= tq + 128); const float sv = ok ? s[e] * sc : -1e30f; s[e] = sv; mx = fmaxf(mx, sv); }
        mx = fmaxf(mx, __shfl_xor(mx, 32));
        float ls = 0.f;
#pragma unroll
        for (int e = 0; e < 16; ++e) { const float pv = s[e] > -1e29f ? fexp2(s[e] - mx) : 0.f; s[e] = pv; ls += pv; }
        ls += __shfl_xor(ls, 32);
        f32x16 o[2];
#pragma unroll
        for (int e = 0; e < 16; ++e) { o[0][e] = 0.f; o[1][e] = 0.f; }
        const int vlane = (4 * h + (i16 >> 2)) * KSTR + (16 * (g4 & 1) + 4 * (i16 & 3)) * 2;
#pragma unroll
        for (int ks = 0; ks < 2; ++ks) {
            v4u pw; pw.x = cpk(s[8 * ks + 0], s[8 * ks + 1]); pw.y = cpk(s[8 * ks + 2], s[8 * ks + 3]); pw.z = cpk(s[8 * ks + 4], s[8 * ks + 5]); pw.w = cpk(s[8 * ks + 6], s[8 * ks + 7]);
            const bf16x8 pb = __builtin_bit_cast(bf16x8, pw);
#pragma unroll
            for (int d0 = 0; d0 < 2; ++d0) {
                LAS const unsigned char* vp = Vw + (16 * ks) * KSTR + d0 * 64 + vlane;
                const bf16x8 vfr = cat8(ldtr(vp), ldtr(vp + 8 * KSTR));
                o[d0] = MFMA32(vfr, pb, o[d0]);
            }
        }
        if (r < nq) {
            if (h == 0) { cm[wid * 16 + r] = mx; cl[wid * 16 + r] = ls; }
#pragma unroll
            for (int d0 = 0; d0 < 2; ++d0)
#pragma unroll
                for (int e = 0; e < 16; ++e) co[(wid * 16 + r) * 64 + d0 * 32 + (e & 3) + 8 * (e >> 2) + 4 * h] = o[d0][e];
        }
    }
    __syncthreads();
    for (int idx = tid; idx < nq * 64; idx += NTHR) {
        const int q = idx >> 6, dd = idx & 63;
        float sink2 = -1e30f; size_t doff;
        if (typ == 1) { const int head = hx * 3 + (q >> 2); sink2 = P.sinks[head] * LOG2E; doff = ((size_t)MP + 4 * b + (q & 3)) * D + head * 64 + dd; }
        else doff = ((size_t)MP + 4 * b + q) * D + TOKW + hx * 64 + dd;
        float ms = sink2;
        for (int w = 0; w < nw; ++w) ms = fmaxf(ms, cm[w * 16 + q]);
        float L = fexp2(sink2 - ms), O = 0.f;
        for (int w = 0; w < nw; ++w) { const float f = fexp2(cm[w * 16 + q] - ms); L += f * cl[w * 16 + q]; O += f * co[(w * 16 + q) * 64 + dd]; }
        ATTp[doff] = (bf16)(cpk(O / L, 0.f) & 0xffffu);
    }
    __syncthreads();
}
#ifndef MEM_FAST8
#define MEM_FAST8 1
#endif
#ifndef SWA_ALLFAST
#define SWA_ALLFAST 1
#endif
#ifndef ATT_QPRE
#define ATT_QPRE 0
#endif
__device__ __forceinline__ void attn_phase(int u_lo, int u_hi, int v_lo, int v_hi, const AttnP& P, ldsp lds, int tid0, int lane0, int wid, int bid, int G) {
    const bf16* const QKVp = (const bf16*)(P.ws + WS_P); bf16* const ATTp = (bf16*)(P.ws + WS_ATT);
    const int n1 = u_hi - u_lo, ntot = n1 + (v_hi - v_lo);
#pragma unroll 1
    for (int ix = bid; ix < ntot; ix += G) {
        const int uu = ix < n1 ? u_lo + ix : v_lo + (ix - n1);
        int tid = tid0; asm volatile("" : "+v"(tid));
        const int lane = tid & 63;
        const int r = lane & 31, h = lane >> 5, i16 = lane & 15, g4 = lane >> 4;
        const int vlane = (4 * h + (i16 >> 2)) * KSTR + (16 * (g4 & 1) + 4 * (i16 & 3)) * 2;
        const int typ = uu < 256 ? 0 : uu < 768 ? 1 : uu < 1024 ? 2 : 3;
        ldsp Ks = lds; ldsp Vs = lds + 384 * KSTR;
        int nitems = 0;
        bf16x8 qf[4]; bool qhave = false;
        if (typ == 0) {
            const int u = uu, b = u >> 6, kvh = (u >> 4) & 3, qblk = u & 15;
            if (ATT_QPRE & 1) {
                const bf16* qp = QKVp + ((size_t)b * SEQ + 256 * qblk + 32 * wid + r) * 1280 + kvh * 3 * 64;
#pragma unroll
                for (int d0 = 0; d0 < 4; ++d0) qf[d0] = *(const bf16x8*)(qp + d0 * 16 + h * 8);
                qhave = true;
            }
            const bf16* kbase = QKVp + (size_t)b * SEQ * 1280 + 768 + kvh * 64;
            stage_bf16_rows2<384>(Ks, Vs, kbase, kbase + 256, 1280, 256 * qblk - 128, tid);
            nitems = 3;
        } else if (typ == 1) {
            sample_attn_unit(1, uu - 256, P, lds, tid, lane, wid); continue;
        } else if (typ == 2) {
            const int u = uu - 768, b = u >> 6, hd = (u >> 4) & 3;
            if (ATT_QPRE & 1) {
                const bf16* qp = (const bf16*)(P.ws + WS_CQ) + ((size_t)b * SEQ + 256 * (u & 15) + 32 * wid + r) * 256 + hd * 64;
#pragma unroll
                for (int d0 = 0; d0 < 4; ++d0) qf[d0] = *(const bf16x8*)(qp + d0 * 16 + h * 8);
                qhave = true;
            }
            stage_bf16_rows2<256>(Ks, Vs, P.MK + (size_t)b * 256 * 256 + hd * 64, P.MK + 1048576 + (size_t)b * 256 * 256 + hd * 64, 256, 0, tid);
            nitems = 1;
        } else {
            sample_attn_unit(3, uu - 1024, P, lds, tid, lane, wid); continue;
        }
        __syncthreads();
#pragma unroll 1
        for (int it = 0; it < nitems; ++it) {
            size_t qoff, doff; int nkb, krow0, klo, khi, kbf = 0; float sink2; bool valid, fast = false, fast8 = false;
            if (typ == 0) {
                const int u = uu, b = u >> 6, kvh = (u >> 4) & 3, qblk = u & 15, item = wid + 8 * it, gq = item >> 3, qsub = item & 7, head = kvh * 3 + gq, q0 = 256 * qblk + 32 * qsub;
                const size_t qrow = (size_t)b * SEQ + q0 + r;
                qoff = qrow * 1280 + head * 64; doff = qrow * D + head * 64; nkb = 5; krow0 = 32 * qsub;
                klo = max(r + 1, 128 - q0); khi = r + 128; sink2 = P.sinks[head] * LOG2E; valid = true; fast = SWA_ALLFAST != 0 || q0 >= 128; kbf = q0 >= 128 ? 0 : (128 - q0) >> 5;
            } else if (typ == 1) {
                const int u = uu - 256, b = u >> 2, kvh = u & 3, rr = r < 12 ? r : 0, gq = rr >> 2, t = rr & 3, head = kvh * 3 + gq;
                const size_t qrow = (size_t)MP + 4 * b + t;
                qoff = qrow * 1280 + head * 64; doff = qrow * D + head * 64; nkb = 5; krow0 = 0;
                klo = t + 1; khi = t + 128; sink2 = P.sinks[head] * LOG2E; valid = r < 12;
            } else if (typ == 2) {
                const int u = uu - 768, b = u >> 6, hd = (u >> 4) & 3, qblk = u & 15;
                const size_t qrow = (size_t)b * SEQ + 256 * qblk + 32 * wid + r;
                qoff = qrow * 256 + hd * 64; doff = qrow * D + TOKW + hd * 64; nkb = 8; krow0 = 0; klo = 0; khi = 1 << 20; sink2 = -1e30f; valid = true; fast8 = MEM_FAST8 != 0;
            } else {
                const int u = uu - 1024, b = u >> 2, hd = u & 3;
                const size_t qrow = (size_t)MP + 4 * b + (r & 3);
                qoff = qrow * 256 + hd * 64; doff = qrow * D + TOKW + hd * 64; nkb = 8; krow0 = 0; klo = 0; khi = 1 << 20; sink2 = -1e30f; valid = r < 4;
            }
            const bf16* qsrc = (const bf16*)(P.ws + ((typ == 0 || typ == 1) ? WS_P : WS_CQ));
            if (!qhave) {
#pragma unroll
                for (int d0 = 0; d0 < 4; ++d0) qf[d0] = *(const bf16x8*)(qsrc + qoff + d0 * 16 + h * 8);
            }
            qhave = false;
            LAS const unsigned char* Kb = Ks + krow0 * KSTR; LAS const unsigned char* Vb = Vs + krow0 * KSTR;
            const float sc = 0.125f * LOG2E;
#define ATT_QK(dst, kb_) do { _Pragma("unroll") for (int e = 0; e < 16; ++e) dst[e] = 0.f; \
                _Pragma("unroll") for (int d0 = 0; d0 < 4; ++d0) { const bf16x8 kf = *(LAS const bf16x8*)(Kb + ((kb_) * 32 + r) * KSTR + d0 * 32 + h * 16); dst = MFMA32(kf, qf[d0], dst); } } while (0)
            float lsum = 0.f, mfin; f32x16 o[2];
#pragma unroll
            for (int e = 0; e < 16; ++e) { o[0][e] = 0.f; o[1][e] = 0.f; }
            if (fast) {
                f32x16 s5[5];
#pragma unroll
                for (int kb = 0; kb < 5; ++kb) ATT_QK(s5[kb], kb);
                __builtin_amdgcn_sched_barrier(0);
                if ((ATT_QPRE & 2) && it + 1 < nitems) {
#pragma unroll
                    for (int d0 = 0; d0 < 4; ++d0) qf[d0] = *(const bf16x8*)(qsrc + qoff + 64 + d0 * 16 + h * 8);
                    qhave = true;
                }
                float mx = -1e30f;
#pragma unroll
                for (int kb = 0; kb < 5; ++kb) {
#pragma unroll
                    for (int e = 0; e < 16; ++e) {
                        const int kin = (e & 3) + 8 * (e >> 2) + 4 * h;
                        float v = s5[kb][e];
                        if (kb < 4) v = (kb < kbf) ? -1e30f : v;
                        if (kb == 0) v = (kin >= r + 1) ? v : -1e30f;
                        if (kb == 4) v = (kin <= r) ? v : -1e30f;
                        s5[kb][e] = v; mx = fmaxf(mx, v);
                    }
                    if (kb == 0 || kb == 4) __builtin_amdgcn_sched_barrier(0);
                }
                mx = fmaxf(mx, __shfl_xor(mx, 32));
                mfin = fmaxf(mx * sc, sink2);
                __builtin_amdgcn_sched_barrier(0);
#pragma unroll
                for (int kb = 0; kb < 5; ++kb) {
#pragma unroll
                    for (int e = 0; e < 16; ++e) { const float pv = fexp2(__builtin_fmaf(s5[kb][e], sc, -mfin)); s5[kb][e] = pv; lsum += pv; }
#pragma unroll
                    for (int ks = 0; ks < 2; ++ks) {
                        v4u pw; pw.x = cpk(s5[kb][8 * ks + 0], s5[kb][8 * ks + 1]); pw.y = cpk(s5[kb][8 * ks + 2], s5[kb][8 * ks + 3]); pw.z = cpk(s5[kb][8 * ks + 4], s5[kb][8 * ks + 5]); pw.w = cpk(s5[kb][8 * ks + 6], s5[kb][8 * ks + 7]);
                        const bf16x8 pb = __builtin_bit_cast(bf16x8, pw);
#pragma unroll
                        for (int d0 = 0; d0 < 2; ++d0) {
                            LAS const unsigned char* vp = Vb + (kb * 32 + 16 * ks) * KSTR + d0 * 64 + vlane;
                            const bf16x8 va = cat8(ldtr(vp), ldtr(vp + 8 * KSTR));
                            o[d0] = MFMA32(va, pb, o[d0]);
                        }
                    }
                    __builtin_amdgcn_sched_barrier(0);
                }
            } else if (fast8) {
                f32x16 s8[8];
#pragma unroll
                for (int kb = 0; kb < 8; ++kb) ATT_QK(s8[kb], kb);
                __builtin_amdgcn_sched_barrier(0);
                float mx = -1e30f;
#pragma unroll
                for (int kb = 0; kb < 8; ++kb)
#pragma unroll
                    for (int e = 0; e < 16; ++e) mx = fmaxf(mx, s8[kb][e]);
                mx = fmaxf(mx, __shfl_xor(mx, 32));
                mfin = mx * sc;
                __builtin_amdgcn_sched_barrier(0);
#pragma unroll
                for (int kb = 0; kb < 8; ++kb) {
#pragma unroll
                    for (int e = 0; e < 16; ++e) { const float pv = fexp2(__builtin_fmaf(s8[kb][e], sc, -mfin)); s8[kb][e] = pv; lsum += pv; }
#pragma unroll
                    for (int ks = 0; ks < 2; ++ks) {
                        v4u pw; pw.x = cpk(s8[kb][8 * ks + 0], s8[kb][8 * ks + 1]); pw.y = cpk(s8[kb][8 * ks + 2], s8[kb][8 * ks + 3]); pw.z = cpk(s8[kb][8 * ks + 4], s8[kb][8 * ks + 5]); pw.w = cpk(s8[kb][8 * ks + 6], s8[kb][8 * ks + 7]);
                        const bf16x8 pb = __builtin_bit_cast(bf16x8, pw);
#pragma unroll
                        for (int d0 = 0; d0 < 2; ++d0) {
                            LAS const unsigned char* vp = Vb + (kb * 32 + 16 * ks) * KSTR + d0 * 64 + vlane;
                            const bf16x8 va = cat8(ldtr(vp), ldtr(vp + 8 * KSTR));
                            o[d0] = MFMA32(va, pb, o[d0]);
                        }
                    }
                    __builtin_amdgcn_sched_barrier(0);
                }
            } else {
            float mx = -1e30f;
            {
                f32x16 sc_; ATT_QK(sc_, 0);
#pragma unroll 2
                for (int kb = 0; kb < nkb; ++kb) {
                    f32x16 sn_; const int kn = kb + 1 < nkb ? kb + 1 : kb; ATT_QK(sn_, kn);
#pragma unroll
                    for (int e = 0; e < 16; ++e) { const int kidx = kb * 32 + (e & 3) + 8 * (e >> 2) + 4 * h; const bool ok = kidx >= klo && kidx <= khi; mx = fmaxf(mx, ok ? sc_[e] * sc : -1e30f); }
                    sc_ = sn_;
                }
            }
            mx = fmaxf(mx, __shfl_xor(mx, 32));
            mfin = fmaxf(mx, sink2);
            {
                f32x16 s; ATT_QK(s, 0);
#pragma unroll 2
                for (int kb = 0; kb < nkb; ++kb) {
                    f32x16 sn_; const int kn = kb + 1 < nkb ? kb + 1 : kb; ATT_QK(sn_, kn);
#pragma unroll
                    for (int e = 0; e < 16; ++e) { const int kidx = kb * 32 + (e & 3) + 8 * (e >> 2) + 4 * h; const bool ok = kidx >= klo && kidx <= khi; const float pv = ok ? fexp2(s[e] * sc - mfin) : 0.f; s[e] = pv; lsum += pv; }
#pragma unroll
                    for (int ks = 0; ks < 2; ++ks) {
                        v4u pw; pw.x = cpk(s[8 * ks + 0], s[8 * ks + 1]); pw.y = cpk(s[8 * ks + 2], s[8 * ks + 3]); pw.z = cpk(s[8 * ks + 4], s[8 * ks + 5]); pw.w = cpk(s[8 * ks + 6], s[8 * ks + 7]);
                        const bf16x8 pb = __builtin_bit_cast(bf16x8, pw);
#pragma unroll
                        for (int d0 = 0; d0 < 2; ++d0) {
                            LAS const unsigned char* vp = Vb + (kb * 32 + 16 * ks) * KSTR + d0 * 64 + vlane;
                            const bf16x8 va = cat8(ldtr(vp), ldtr(vp + 8 * KSTR));
                            o[d0] = MFMA32(va, pb, o[d0]);
                        }
                    }
                    s = sn_;
                }
            }
            }
#undef ATT_QK
            const float ltot = lsum + __shfl_xor(lsum, 32) + fexp2(sink2 - mfin);
            const float linv = 1.0f / ltot;
            if (valid) {
                bf16* dst = ATTp + doff;
#pragma unroll
                for (int d0 = 0; d0 < 2; ++d0)
#pragma unroll
                    for (int rg = 0; rg < 4; ++rg)
                        *(unsigned long long*)(dst + d0 * 32 + 8 * rg + 4 * h) = (unsigned long long)cpk(o[d0][4 * rg] * linv, o[d0][4 * rg + 1] * linv) | ((unsigned long long)cpk(o[d0][4 * rg + 2] * linv, o[d0][4 * rg + 3] * linv) << 32);
            }
        }
        __syncthreads();
    }
}

__device__ __forceinline__ void hg_sample_phase(ldsp lds, const float* lbp, const bf16* QF, const bf16* VI, const bf16* OG, const lf_t* ZF, const float* S0, float* Sout, bf16* ATT, int tid, int bid, int G) {
    const int v = tid & 127, kg = tid >> 7, lane = tid & 63, wid = tid >> 6;
    LAS float* vq = (LAS float*)lds;
    LAS float* vf = vq + 512;
    LAS float* vk = vf + 512;
    LAS float* po = vk + 512;
    LAS float* red = po + 2048;
    float Sn[32]; unsigned short qn, vvn[4], ogn[4]; float zn; int hhn = 0;
#define HGS_LOAD(u_) do { const int b_ = (u_) / 6, hh_ = (u_) % 6; \
        const float* s0_ = S0 + ((size_t)b_ * 6 + hh_) * 16384 + (size_t)(kg * 32) * 128 + v; \
        _Pragma("unroll") for (int i = 0; i < 32; ++i) Sn[i] = __builtin_nontemporal_load(s0_ + (size_t)i * 128); \
        const size_t off_ = ((size_t)MP + 4 * b_ + kg) * 768 + hh_ * 128 + v; qn = QF[off_]; zn = (float)ZF[off_]; hhn = hh_; \
        _Pragma("unroll") for (int t = 0; t < 4; ++t) { const size_t o2_ = ((size_t)MP + 4 * b_ + t) * 768 + hh_ * 128 + v; vvn[t] = VI[o2_]; ogn[t] = OG[o2_]; } } while (0)
    if (bid < 768) HGS_LOAD(bid);
#pragma unroll 1
    for (int u = bid; u < 768; u += G) {
        const int b = u / 6, hh = u % 6;
        { const float lb = lbp[hhn * 128 + v], sg = fsigmoid(zn); vq[tid] = bf2f(qn); vf[tid] = lb + (1.0f - lb) * sg; vk[tid] = (1.0f - lb) * fsigmoid(-zn); }
        float S[32], vv[4], og[4];
#pragma unroll
        for (int i = 0; i < 32; ++i) S[i] = Sn[i];
#pragma unroll
        for (int t = 0; t < 4; ++t) { vv[t] = bf2f(vvn[t]); og[t] = bf2f(ogn[t]); }
        if (u + G < 768) HGS_LOAD(u + G);
        __syncthreads();
#pragma unroll
        for (int t = 0; t < 4; ++t) {
            float po_ = 0.f;
#pragma unroll
            for (int i = 0; i < 32; ++i) { const int k = kg * 32 + i; S[i] = vf[t * 128 + k] * S[i] + vk[t * 128 + k] * vv[t]; po_ += S[i] * vq[t * 128 + k]; }
            po[(t * 4 + kg) * 128 + v] = po_;
        }
        float* so = Sout + ((size_t)b * 6 + hh) * 16384 + (size_t)(kg * 32) * 128 + v;
#pragma unroll
        for (int i = 0; i < 32; ++i) __builtin_nontemporal_store(S[i], so + (size_t)i * 128);
        __syncthreads();
        float ov[4];
#pragma unroll
        for (int t = 0; t < 4; ++t) { ov[t] = (po[(t * 4 + 0) * 128 + v] + po[(t * 4 + 1) * 128 + v]) + (po[(t * 4 + 2) * 128 + v] + po[(t * 4 + 3) * 128 + v]);
            const float sq = wave_sum(ov[t] * ov[t]); if (lane == 0) red[t * 8 + wid] = sq; }
        __syncthreads();
        if (kg == 0) {
#pragma unroll
            for (int t = 0; t < 4; ++t) { const float rs = __builtin_amdgcn_rsqf((red[t * 8] + red[t * 8 + 1]) * (1.0f / 128.0f) + EPS);
                ATT[((size_t)MP + 4 * b + t) * D + hh * 128 + v] = (bf16)(cpk(ov[t] * rs * og[t], 0.f) & 0xffffu); }
        }
    }
#undef HGS_LOAD
    __syncthreads();
}

constexpr int QSTR = 272, ASTR = 144, KTSTR = 144;
struct HgPre { lf_t z[16]; v4u v[2]; };
__device__ __forceinline__ void hg_pre_load(HgPre& R, const bf16* VI, const lf_t* ZF, int unit, int tid) {
    const int n = unit & 63, bh = unit >> 6, b = bh / 6, hh = bh % 6, col0 = hh * 128, c = tid & 127, I = tid >> 7;
    const size_t m0 = (size_t)b * SEQ + 64 * n;
#pragma unroll
    for (int i = 0; i < 16; ++i) R.z[i] = ZF[(m0 + 16 * I + i) * 768 + col0 + c];
#pragma unroll
    for (int k = 0; k < 2; ++k) { const int idx = tid + NTHR * k, row = idx >> 4, ch = idx & 15; R.v[k] = *(const v4u*)(VI + (m0 + row) * 768 + col0 + ch * 8); }
}
__device__ __forceinline__ void hg_gate(float z, float lb, float& lf2, float& kf) {
    const float sg = fsigmoid(z), om = 1.0f - lb;
    lf2 = fmaxf(__builtin_amdgcn_logf(lb + om * sg), -100.0f);
    kf = om * (1.0f - sg);
}
__device__ __forceinline__ void hg_pre_vstore(const HgPre& R, ldsp Vs, int tid) {
#pragma unroll
    for (int k = 0; k < 2; ++k) { const int idx = tid + NTHR * k, row = idx >> 4, ch = idx & 15; *(LAS v4u*)(Vs + row * QSTR + ch * 16) = R.v[k]; }
}
struct HgCum { float loc[16]; float kfv[16]; float bI; float tj[4]; };
__device__ __forceinline__ void hg_cum(HgCum& F, const HgPre& R, float lb, LAS float* tot, int tid) {
    const int c = tid & 127, I = tid >> 7;
    float run = 0.f;
#pragma unroll
    for (int i = 0; i < 16; ++i) { float lf2; hg_gate((float)R.z[i], lb, lf2, F.kfv[i]); run += lf2; F.loc[i] = run; }
    tot[I * 128 + c] = run;
    __syncthreads();
#pragma unroll
    for (int j = 0; j < 4; ++j) F.tj[j] = tot[j * 128 + c];
    F.bI = 0.f;
#pragma unroll
    for (int j = 0; j < 3; ++j) if (j < I) F.bI += F.tj[j];
}
__device__ __forceinline__ bf16x8 hg_vt_frag(ldsp Vs, int vb, int ks, int lane) {
    const int h = lane >> 5, i16 = lane & 15, g = lane >> 4;
    LAS const unsigned char* p = Vs + (16 * ks + 8 * h + (i16 >> 2)) * QSTR + (vb * 32 + 16 * (g & 1) + 4 * (i16 & 3)) * 2;
    return cat8(ldtr(p), ldtr(p + 4 * QSTR));
}
__device__ __forceinline__ void hg_h1_phase(ldsp lds, const float* lbp, const bf16* VI, const lf_t* ZF, bf16* U, float* DD, int tid, int lane, int wid, int bid, int G) {
    ldsp KT = lds, Vs = lds + 128 * KTSTR; LAS float* tot = (LAS float*)(lds + 128 * KTSTR + 64 * QSTR);
    const int c = tid & 127, I = tid >> 7, r = lane & 31, h = lane >> 5, vb = wid >> 1, cb0 = 2 * (wid & 1);
    HgPre R;
    if (bid < 1536) hg_pre_load(R, VI, ZF, bid, tid);
#pragma unroll 1
    for (int unit = bid; unit < 1536; unit += G) {
        const float lb = lbp[((unit >> 6) % 6) * 128 + c];
        HgCum F; hg_cum(F, R, lb, tot, tid);
        const float total = (F.tj[0] + F.tj[1]) + (F.tj[2] + F.tj[3]);
        {
            float kt[16];
#pragma unroll
            for (int i = 0; i < 16; ++i) kt[i] = F.kfv[i] * fexp2(total - F.bI - F.loc[i]);
            v4u w0, w1;
            w0.x = cpk(kt[0], kt[1]); w0.y = cpk(kt[2], kt[3]); w0.z = cpk(kt[4], kt[5]); w0.w = cpk(kt[6], kt[7]);
            w1.x = cpk(kt[8], kt[9]); w1.y = cpk(kt[10], kt[11]); w1.z = cpk(kt[12], kt[13]); w1.w = cpk(kt[14], kt[15]);
            *(LAS v4u*)(KT + c * KTSTR + 32 * I) = w0; *(LAS v4u*)(KT + c * KTSTR + 32 * I + 16) = w1;
        }
        hg_pre_vstore(R, Vs, tid);
        if (I == 0) DD[(size_t)unit * 128 + c] = fexp2(total);
        if (unit + G < 1536) hg_pre_load(R, VI, ZF, unit + G, tid);
        __syncthreads();
        f32x16 acc[2];
#pragma unroll
        for (int e = 0; e < 16; ++e) { acc[0][e] = 0.f; acc[1][e] = 0.f; }
#pragma unroll
        for (int ks = 0; ks < 4; ++ks) {
            const bf16x8 vfr = hg_vt_frag(Vs, vb, ks, lane);
#pragma unroll
            for (int cc = 0; cc < 2; ++cc) { const bf16x8 ka = *(LAS const bf16x8*)(KT + ((cb0 + cc) * 32 + r) * KTSTR + (16 * ks + 8 * h) * 2); acc[cc] = MFMA32(ka, vfr, acc[cc]); }
        }
        bf16* Uu = U + ((size_t)unit * 128 + vb * 32 + r) * 128;
#pragma unroll
        for (int cc = 0; cc < 2; ++cc)
#pragma unroll
            for (int rg = 0; rg < 4; ++rg)
                *(unsigned long long*)(Uu + (cb0 + cc) * 32 + 8 * rg + 4 * h) = (unsigned long long)cpk(acc[cc][4 * rg], acc[cc][4 * rg + 1]) | ((unsigned long long)cpk(acc[cc][4 * rg + 2], acc[cc][4 * rg + 3]) << 32);
        __syncthreads();
    }
}
__device__ __forceinline__ void hg_h2(const bf16* U, const float* DD, bf16* ST, float* fin, int gtid) {
    if (gtid >= 24 * 4096) return;
    const int bh = gtid >> 12, e4 = gtid & 4095, v = e4 >> 5, c4 = (e4 & 31) * 4;
    f32x4 S = {0.f, 0.f, 0.f, 0.f};
#pragma unroll 1
    for (int n0 = 0; n0 < 64; n0 += 8) {
        f32x4 uu[8], dd[8]; unsigned long long uw[8];
#pragma unroll
        for (int k = 0; k < 8; ++k) { const size_t unit = (size_t)bh * 64 + n0 + k; uw[k] = *(const unsigned long long*)(U + (unit * 128 + v) * 128 + c4); dd[k] = *(const f32x4*)(DD + unit * 128 + c4); }
#pragma unroll
        for (int k = 0; k < 8; ++k) uu[k] = (f32x4){bf2f((unsigned short)uw[k]), bf2f((unsigned short)(uw[k] >> 16)), bf2f((unsigned short)(uw[k] >> 32)), bf2f((unsigned short)(uw[k] >> 48))};
#pragma unroll
        for (int k = 0; k < 8; ++k) { const size_t unit = (size_t)bh * 64 + n0 + k;
            *(unsigned long long*)(ST + (unit * 128 + v) * 128 + c4) = (unsigned long long)cpk(S[0], S[1]) | ((unsigned long long)cpk(S[2], S[3]) << 32);
            S = dd[k] * S + uu[k]; }
    }
    float* f = fin + (size_t)bh * 16384 + v;
#pragma unroll
    for (int e = 0; e < 4; ++e) f[(size_t)(c4 + e) * 128] = S[e];
}
struct HgPreQ { unsigned short q[16]; };
__device__ __forceinline__ void hg_preq_load(HgPreQ& Q, const bf16* QF, int unit, int tid) {
    const int n = unit & 63, bh = unit >> 6, b = bh / 6, hh = bh % 6, col0 = hh * 128, c = tid & 127, I = tid >> 7;
    const size_t m0 = (size_t)b * SEQ + 64 * n;
#pragma unroll
    for (int i = 0; i < 16; ++i) Q.q[i] = QF[(m0 + 16 * I + i) * 768 + col0 + c];
}
__device__ __forceinline__ void hg_h3_phase(ldsp lds, const float* lbp, const bf16* QF, const bf16* VI, const bf16* OG, const lf_t* ZF, const bf16* ST, bf16* ATT, int tid, int lane, int wid, int bid, int G) {
    ldsp QI = lds, Q0 = QI + 64 * QSTR, KX = Q0 + 64 * QSTR, Vs = KX + 160 * QSTR, AT = Vs + 64 * QSTR;
    LAS float* tot = (LAS float*)(AT + 64 * ASTR); LAS float* red = tot + 512;
    const int c = tid & 127, I = tid >> 7, r = lane & 31, h = lane >> 5, vb = wid >> 1, tb = wid & 1;
    HgPre R; HgPreQ Q;
    if (bid < 1536) { hg_pre_load(R, VI, ZF, bid, tid); hg_preq_load(Q, QF, bid, tid); }
#pragma unroll 1
    for (int unit = bid; unit < 1536; unit += G) {
        const int n = unit & 63, bh = unit >> 6, b = bh / 6, hh = bh % 6, col0 = hh * 128;
        const size_t m0 = (size_t)b * SEQ + 64 * n;
        bf16x8 sa[8]; unsigned long long ogw[4];
        {
            const bf16* Su = ST + ((size_t)unit * 128 + vb * 32 + r) * 128;
#pragma unroll
            for (int ks = 0; ks < 8; ++ks) sa[ks] = *(const bf16x8*)(Su + 16 * ks + 8 * h);
            const size_t row = m0 + tb * 32 + r;
#pragma unroll
            for (int rg = 0; rg < 4; ++rg) ogw[rg] = *(const unsigned long long*)(OG + row * 768 + col0 + vb * 32 + 8 * rg + 4 * h);
        }
        for (int idx = tid; idx < 64 * ASTR / 16; idx += NTHR) *(LAS v4u*)(AT + idx * 16) = (v4u){0u, 0u, 0u, 0u};
        HgCum F; hg_cum(F, R, lbp[hh * 128 + c], tot, tid);
        {
            float bJ[4]; bJ[0] = 0.f; bJ[1] = F.tj[0]; bJ[2] = F.tj[0] + F.tj[1]; bJ[3] = (F.tj[0] + F.tj[1]) + F.tj[2];
            const float ebI = fexp2(F.bI);
            float eJ[4];
#pragma unroll
            for (int Ip = 0; Ip < 4; ++Ip) eJ[Ip] = fexp2(bJ[Ip] - F.bI);
#pragma unroll
            for (int i = 0; i < 16; ++i) {
                const int t = 16 * I + i;
                const float qi = bf2f(Q.q[i]) * fexp2(F.loc[i]), kv = F.kfv[i] * fexp2(fminf(-F.loc[i], 80.0f));
                *(LAS bf16*)(QI + t * QSTR + c * 2) = (bf16)(cpk(qi, 0.f) & 0xffffu);
                *(LAS bf16*)(Q0 + t * QSTR + c * 2) = (bf16)(cpk(qi * ebI, 0.f) & 0xffffu);
#pragma unroll
                for (int Ip = 0; Ip < 4; ++Ip)
                    if (Ip >= I) *(LAS bf16*)(KX + (8 * Ip * (Ip + 1) + t) * QSTR + c * 2) = (bf16)(cpk(kv * eJ[Ip], 0.f) & 0xffffu);
            }
        }
        hg_pre_vstore(R, Vs, tid);
        if (unit + G < 1536) { hg_pre_load(R, VI, ZF, unit + G, tid); hg_preq_load(Q, QF, unit + G, tid); }
        __syncthreads();
        {
            const int r16 = lane & 15, kq = lane >> 4;
            for (int p = wid; p < 10; p += 8) {
                const int Ip = p < 1 ? 0 : p < 3 ? 1 : p < 6 ? 2 : 3, J = p - (Ip * (Ip + 1)) / 2;
                f32x4 a4 = {0.f, 0.f, 0.f, 0.f};
#pragma unroll
                for (int kst = 0; kst < 4; ++kst) {
                    const bf16x8 af = *(LAS const bf16x8*)(KX + (8 * Ip * (Ip + 1) + 16 * J + r16) * QSTR + (32 * kst + 8 * kq) * 2);
                    const bf16x8 bfr = *(LAS const bf16x8*)(QI + (16 * Ip + r16) * QSTR + (32 * kst + 8 * kq) * 2);
                    a4 = MFMA16(af, bfr, a4);
                }
                const int t = 16 * Ip + r16, s0 = 16 * J + 4 * kq;
                float w[4];
#pragma unroll
                for (int e = 0; e < 4; ++e) w[e] = (s0 + e <= t) ? a4[e] : 0.f;
                *(LAS unsigned long long*)(AT + t * ASTR + s0 * 2) = (unsigned long long)cpk(w[0], w[1]) | ((unsigned long long)cpk(w[2], w[3]) << 32);
            }
        }
        __syncthreads();
        f32x16 acc;
#pragma unroll
        for (int e = 0; e < 16; ++e) acc[e] = 0.f;
#pragma unroll
        for (int ks = 0; ks < 4; ++ks) {
            const bf16x8 va = hg_vt_frag(Vs, vb, ks, lane);
            const bf16x8 ab = *(LAS const bf16x8*)(AT + (tb * 32 + r) * ASTR + (16 * ks + 8 * h) * 2);
            acc = MFMA32(va, ab, acc);
        }
#pragma unroll
        for (int ks = 0; ks < 8; ++ks) {
            const bf16x8 qb = *(LAS const bf16x8*)(Q0 + (tb * 32 + r) * QSTR + (16 * ks + 8 * h) * 2);
            acc = MFMA32(sa[ks], qb, acc);
        }
        float ss = 0.f;
#pragma unroll
        for (int e = 0; e < 16; ++e) ss += acc[e] * acc[e];
        ss += __shfl_xor(ss, 32);
        if (h == 0) red[vb * 64 + tb * 32 + r] = ss;
        __syncthreads();
        const int t = tb * 32 + r;
        const float tot2 = (red[t] + red[64 + t]) + (red[128 + t] + red[192 + t]);
        const float rs = __builtin_amdgcn_rsqf(tot2 * (1.0f / 128.0f) + EPS);
        const size_t row = m0 + t;
#pragma unroll
        for (int rg = 0; rg < 4; ++rg) {
            const int v0 = vb * 32 + 8 * rg + 4 * h;
            const unsigned long long gw = ogw[rg];
            const float g0 = bf2f((unsigned short)gw), g1 = bf2f((unsigned short)(gw >> 16)), g2 = bf2f((unsigned short)(gw >> 32)), g3 = bf2f((unsigned short)(gw >> 48));
            *(unsigned long long*)(ATT + row * D + col0 + v0) = (unsigned long long)cpk(acc[4 * rg] * rs * g0, acc[4 * rg + 1] * rs * g1) | ((unsigned long long)cpk(acc[4 * rg + 2] * rs * g2, acc[4 * rg + 3] * rs * g3) << 32);
        }
        __syncthreads();
    }
}

__device__ __forceinline__ void hg_h1p_phase(ldsp lds, const float* lbp, const bf16* VI, const lf_t* ZF, bf16* U, float* DD, int tid, int lane, int wid, int bid, int G) {
    ldsp KT = lds, Vs = lds + 128 * KTSTR; LAS float* tot = (LAS float*)(lds + 128 * KTSTR + 64 * QSTR); LAS float* ttot = tot + 512;
    const int c = tid & 127, I = tid >> 7, r = lane & 31, h = lane >> 5, vb = wid >> 1, cb0 = 2 * (wid & 1);
    HgPre R;
    if (bid < 768) hg_pre_load(R, VI, ZF, 2 * bid, tid);
#pragma unroll 1
    for (int pr = bid; pr < 768; pr += G) {
        const float lb = lbp[((pr >> 5) % 6) * 128 + c];
        f32x16 acc[2];
#pragma unroll
        for (int e = 0; e < 16; ++e) { acc[0][e] = 0.f; acc[1][e] = 0.f; }
        float dsum = 0.f;
#pragma unroll 1
        for (int k = 0; k < 2; ++k) {
            HgCum F; hg_cum(F, R, lb, tot, tid);
            const float total = (F.tj[0] + F.tj[1]) + (F.tj[2] + F.tj[3]);
            {
                float kt[16];
#pragma unroll
                for (int i = 0; i < 16; ++i) kt[i] = F.kfv[i] * fexp2(total - F.bI - F.loc[i]);
                v4u w0, w1;
                w0.x = cpk(kt[0], kt[1]); w0.y = cpk(kt[2], kt[3]); w0.z = cpk(kt[4], kt[5]); w0.w = cpk(kt[6], kt[7]);
                w1.x = cpk(kt[8], kt[9]); w1.y = cpk(kt[10], kt[11]); w1.z = cpk(kt[12], kt[13]); w1.w = cpk(kt[14], kt[15]);
                *(LAS v4u*)(KT + c * KTSTR + 32 * I) = w0; *(LAS v4u*)(KT + c * KTSTR + 32 * I + 16) = w1;
            }
            hg_pre_vstore(R, Vs, tid);
            if (I == 0) ttot[c] = fexp2(total);
            dsum += total;
            { const int nu = (k == 0) ? 2 * pr + 1 : 2 * (pr + G); if (nu < 1536) hg_pre_load(R, VI, ZF, nu, tid); }
            __syncthreads();
            if (k == 1) {
#pragma unroll
                for (int cc = 0; cc < 2; ++cc)
#pragma unroll
                    for (int e = 0; e < 16; ++e) acc[cc][e] *= ttot[(cb0 + cc) * 32 + (e & 3) + 8 * (e >> 2) + 4 * h];
            }
#pragma unroll
            for (int ks = 0; ks < 4; ++ks) {
                const bf16x8 vfr = hg_vt_frag(Vs, vb, ks, lane);
#pragma unroll
                for (int cc = 0; cc < 2; ++cc) { const bf16x8 ka = *(LAS const bf16x8*)(KT + ((cb0 + cc) * 32 + r) * KTSTR + (16 * ks + 8 * h) * 2); acc[cc] = MFMA32(ka, vfr, acc[cc]); }
            }
            __syncthreads();
        }
        if (I == 0) DD[(size_t)pr * 128 + c] = fexp2(dsum);
        bf16* Uu = U + ((size_t)pr * 128 + vb * 32 + r) * 128;
#pragma unroll
        for (int cc = 0; cc < 2; ++cc)
#pragma unroll
            for (int rg = 0; rg < 4; ++rg)
                *(unsigned long long*)(Uu + (cb0 + cc) * 32 + 8 * rg + 4 * h) = (unsigned long long)cpk(acc[cc][4 * rg], acc[cc][4 * rg + 1]) | ((unsigned long long)cpk(acc[cc][4 * rg + 2], acc[cc][4 * rg + 3]) << 32);
    }
}
__device__ __forceinline__ void hg_h2p(const bf16* U, const float* DD, bf16* ST, float* fin, int gtid) {
    if (gtid >= 24 * 4096) return;
    const int bh = gtid >> 12, e4 = gtid & 4095, v = e4 >> 5, c4 = (e4 & 31) * 4;
    f32x4 S = {0.f, 0.f, 0.f, 0.f};
#pragma unroll 1
    for (int n0 = 0; n0 < 32; n0 += 8) {
        f32x4 uu[8], dd[8]; unsigned long long uw[8];
#pragma unroll
        for (int k = 0; k < 8; ++k) { const size_t unit = (size_t)bh * 32 + n0 + k; uw[k] = *(const unsigned long long*)(U + (unit * 128 + v) * 128 + c4); dd[k] = *(const f32x4*)(DD + unit * 128 + c4); }
#pragma unroll
        for (int k = 0; k < 8; ++k) uu[k] = (f32x4){bf2f((unsigned short)uw[k]), bf2f((unsigned short)(uw[k] >> 16)), bf2f((unsigned short)(uw[k] >> 32)), bf2f((unsigned short)(uw[k] >> 48))};
#pragma unroll
        for (int k = 0; k < 8; ++k) { const size_t unit = (size_t)bh * 32 + n0 + k;
            *(unsigned long long*)(ST + (unit * 128 + v) * 128 + c4) = (unsigned long long)cpk(S[0], S[1]) | ((unsigned long long)cpk(S[2], S[3]) << 32);
            S = dd[k] * S + uu[k]; }
    }
    float* f = fin + (size_t)bh * 16384 + v;
#pragma unroll
    for (int e = 0; e < 4; ++e) f[(size_t)(c4 + e) * 128] = S[e];
}
__device__ __forceinline__ void hg_h3p_phase(ldsp lds, const float* lbp, const bf16* QF, const bf16* VI, const bf16* OG, const lf_t* ZF, const bf16* ST, bf16* ATT, int tid, int lane, int wid, int bid, int G) {
    ldsp QI = lds, Q0 = QI + 64 * QSTR, KX = Q0 + 64 * QSTR, Vs = KX + 160 * QSTR, AT = Vs + 64 * QSTR;
    LAS float* tot = (LAS float*)(AT + 64 * ASTR); LAS float* red = tot + 512; LAS float* ttot = red + 256;
    ldsp KT = (ldsp)(ttot + 128);
    const int c = tid & 127, I = tid >> 7, r = lane & 31, h = lane >> 5, vb = wid >> 1, tb = wid & 1;
    HgPre R; HgPreQ Q;
    if (bid < 768) { hg_pre_load(R, VI, ZF, 2 * bid, tid); hg_preq_load(Q, QF, 2 * bid, tid); }
#pragma unroll 1
    for (int pr = bid; pr < 768; pr += G) {
        const int bh = pr >> 5, b = bh / 6, hh = bh % 6, col0 = hh * 128;
        const float lb = lbp[hh * 128 + c];
        f32x16 Sreg[4];
        {
            const bf16* Sp = ST + ((size_t)pr * 128 + vb * 32 + r) * 128;
#pragma unroll
            for (int cb = 0; cb < 4; ++cb)
#pragma unroll
                for (int rg = 0; rg < 4; ++rg) { const unsigned long long w = *(const unsigned long long*)(Sp + cb * 32 + 8 * rg + 4 * h);
                    Sreg[cb][4 * rg] = bf2f((unsigned short)w); Sreg[cb][4 * rg + 1] = bf2f((unsigned short)(w >> 16)); Sreg[cb][4 * rg + 2] = bf2f((unsigned short)(w >> 32)); Sreg[cb][4 * rg + 3] = bf2f((unsigned short)(w >> 48)); }
        }
#pragma unroll 1
        for (int k = 0; k < 2; ++k) {
            const int n = (2 * pr + k) & 63;
            const size_t m0 = (size_t)b * SEQ + 64 * n;
            unsigned long long ogw[4];
            {
                const size_t row = m0 + tb * 32 + r;
#pragma unroll
                for (int rg = 0; rg < 4; ++rg) ogw[rg] = *(const unsigned long long*)(OG + row * 768 + col0 + vb * 32 + 8 * rg + 4 * h);
            }
            for (int idx = tid; idx < 64 * ASTR / 16; idx += NTHR) *(LAS v4u*)(AT + idx * 16) = (v4u){0u, 0u, 0u, 0u};
            HgCum F; hg_cum(F, R, lb, tot, tid);
            {
                float bJ[4]; bJ[0] = 0.f; bJ[1] = F.tj[0]; bJ[2] = F.tj[0] + F.tj[1]; bJ[3] = (F.tj[0] + F.tj[1]) + F.tj[2];
                const float ebI = fexp2(F.bI), total = bJ[3] + F.tj[3];
                if (I == 0) ttot[c] = fexp2(total);
                float eJ[4];
#pragma unroll
                for (int Ip = 0; Ip < 4; ++Ip) eJ[Ip] = fexp2(bJ[Ip] - F.bI);
                float kt[16];
#pragma unroll
                for (int i = 0; i < 16; ++i) {
                    const int t = 16 * I + i;
                    const float qi = bf2f(Q.q[i]) * fexp2(F.loc[i]), kv = F.kfv[i] * fexp2(fminf(-F.loc[i], 80.0f));
                    kt[i] = F.kfv[i] * fexp2(total - F.bI - F.loc[i]);
                    *(LAS bf16*)(QI + t * QSTR + c * 2) = (bf16)(cpk(qi, 0.f) & 0xffffu);
                    *(LAS bf16*)(Q0 + t * QSTR + c * 2) = (bf16)(cpk(qi * ebI, 0.f) & 0xffffu);
#pragma unroll
                    for (int Ip = 0; Ip < 4; ++Ip)
                        if (Ip >= I) *(LAS bf16*)(KX + (8 * Ip * (Ip + 1) + t) * QSTR + c * 2) = (bf16)(cpk(kv * eJ[Ip], 0.f) & 0xffffu);
                }
                if (k == 0) {
                    v4u w0, w1;
                    w0.x = cpk(kt[0], kt[1]); w0.y = cpk(kt[2], kt[3]); w0.z = cpk(kt[4], kt[5]); w0.w = cpk(kt[6], kt[7]);
                    w1.x = cpk(kt[8], kt[9]); w1.y = cpk(kt[10], kt[11]); w1.z = cpk(kt[12], kt[13]); w1.w = cpk(kt[14], kt[15]);
                    *(LAS v4u*)(KT + c * KTSTR + 32 * I) = w0; *(LAS v4u*)(KT + c * KTSTR + 32 * I + 16) = w1;
                }
            }
            hg_pre_vstore(R, Vs, tid);
            { const int nu = (k == 0) ? 2 * pr + 1 : 2 * (pr + G); if (nu < 1536) { hg_pre_load(R, VI, ZF, nu, tid); hg_preq_load(Q, QF, nu, tid); } }
            __syncthreads();
            {
                const int r16 = lane & 15, kq = lane >> 4;
                for (int p = wid; p < 10; p += 8) {
                    const int Ip = p < 1 ? 0 : p < 3 ? 1 : p < 6 ? 2 : 3, J = p - (Ip * (Ip + 1)) / 2;
                    f32x4 a4 = {0.f, 0.f, 0.f, 0.f};
#pragma unroll
                    for (int kst = 0; kst < 4; ++kst) {
                        const bf16x8 af = *(LAS const bf16x8*)(KX + (8 * Ip * (Ip + 1) + 16 * J + r16) * QSTR + (32 * kst + 8 * kq) * 2);
                        const bf16x8 bfr = *(LAS const bf16x8*)(QI + (16 * Ip + r16) * QSTR + (32 * kst + 8 * kq) * 2);
                        a4 = MFMA16(af, bfr, a4);
                    }
                    const int t = 16 * Ip + r16, s0 = 16 * J + 4 * kq;
                    float w[4];
#pragma unroll
                    for (int e = 0; e < 4; ++e) w[e] = (s0 + e <= t) ? a4[e] : 0.f;
                    *(LAS unsigned long long*)(AT + t * ASTR + s0 * 2) = (unsigned long long)cpk(w[0], w[1]) | ((unsigned long long)cpk(w[2], w[3]) << 32);
                }
            }
            __syncthreads();
            f32x16 acc;
#pragma unroll
            for (int e = 0; e < 16; ++e) acc[e] = 0.f;
#pragma unroll
            for (int ks = 0; ks < 4; ++ks) {
                const bf16x8 va = hg_vt_frag(Vs, vb, ks, lane);
                const bf16x8 ab = *(LAS const bf16x8*)(AT + (tb * 32 + r) * ASTR + (16 * ks + 8 * h) * 2);
                acc = MFMA32(va, ab, acc);
            }
#pragma unroll
            for (int cb = 0; cb < 4; ++cb)
#pragma unroll
                for (int s = 0; s < 2; ++s) {
                    v4u pw; pw.x = cpk(Sreg[cb][8 * s + 0], Sreg[cb][8 * s + 1]); pw.y = cpk(Sreg[cb][8 * s + 2], Sreg[cb][8 * s + 3]); pw.z = cpk(Sreg[cb][8 * s + 4], Sreg[cb][8 * s + 5]); pw.w = cpk(Sreg[cb][8 * s + 6], Sreg[cb][8 * s + 7]);
                    LAS const unsigned char* qp = Q0 + (tb * 32 + r) * QSTR + (32 * cb + 16 * s + 4 * h) * 2;
                    const bf16x8 qb = cat8(*(LAS const s16x4*)qp, *(LAS const s16x4*)(qp + 16));
                    acc = MFMA32(__builtin_bit_cast(bf16x8, pw), qb, acc);
                }
            float ss = 0.f;
#pragma unroll
            for (int e = 0; e < 16; ++e) ss += acc[e] * acc[e];
            ss += __shfl_xor(ss, 32);
            if (h == 0) red[vb * 64 + tb * 32 + r] = ss;
            if (k == 0) {
#pragma unroll
                for (int cb = 0; cb < 4; ++cb)
#pragma unroll
                    for (int e = 0; e < 16; ++e) Sreg[cb][e] *= ttot[cb * 32 + (e & 3) + 8 * (e >> 2) + 4 * h];
#pragma unroll
                for (int ks = 0; ks < 4; ++ks) {
                    const bf16x8 vfr = hg_vt_frag(Vs, vb, ks, lane);
#pragma unroll
                    for (int cb = 0; cb < 4; ++cb) { const bf16x8 ka = *(LAS const bf16x8*)(KT + (cb * 32 + r) * KTSTR + (16 * ks + 8 * h) * 2); Sreg[cb] = MFMA32(ka, vfr, Sreg[cb]); }
                }
            }
            __syncthreads();
            const int t = tb * 32 + r;
            const float tot2 = (red[t] + red[64 + t]) + (red[128 + t] + red[192 + t]);
            const float rs = __builtin_amdgcn_rsqf(tot2 * (1.0f / 128.0f) + EPS);
            const size_t row = m0 + t;
#pragma unroll
            for (int rg = 0; rg < 4; ++rg) {
                const int v0 = vb * 32 + 8 * rg + 4 * h;
                const unsigned long long gw = ogw[rg];
                const float g0 = bf2f((unsigned short)gw), g1 = bf2f((unsigned short)(gw >> 16)), g2 = bf2f((unsigned short)(gw >> 32)), g3 = bf2f((unsigned short)(gw >> 48));
                *(unsigned long long*)(ATT + row * D + col0 + v0) = (unsigned long long)cpk(acc[4 * rg] * rs * g0, acc[4 * rg + 1] * rs * g1) | ((unsigned long long)cpk(acc[4 * rg + 2] * rs * g2, acc[4 * rg + 3] * rs * g3) << 32);
            }
            __syncthreads();
        }
    }
}

#ifndef MK_PER_PHASE
#define MK_PER_PHASE 0
#endif
constexpr int N_PHASES = 25;
#ifndef HG_PAIRS
#define HG_PAIRS 1
#endif
#ifndef SWA_LATE
#define SWA_LATE 1
#endif
#ifndef HG_LATE
#define HG_LATE 1
#endif
#ifndef HG_MEM_KEEP
#define HG_MEM_KEEP 0
#endif
#ifndef SWA_MEM_KEEP
#define SWA_MEM_KEEP 0
#endif
#ifndef SWA_KEEP
#define SWA_KEEP 0
#endif
enum Kind { K_PRO = 0, K_G1H, K_MIX, K_H2, K_H3, K_G1S, K_G2, K_G3, K_G4 };

__global__ void __launch_bounds__(NTHR, 2) fwd_kernel(Args a) {
    extern __shared__ __attribute__((aligned(16))) unsigned char lds_raw[];
    ldsp lds = (ldsp)lds_raw;
    const int tid0 = threadIdx.x, bid0 = blockIdx.x, G0 = gridDim.x;
    const int wid0 = __builtin_amdgcn_readfirstlane(tid0 >> 6);
    volatile LAS unsigned* MISC = (volatile LAS unsigned*)(lds + MISC_OFF);
    for (int u = tid0; u < (LDS_BYTES - RING_BYTES) / 4; u += NTHR) ((LAS unsigned*)(lds + RING_BYTES))[u] = 0u;
    __syncthreads();
    XcdBarrier bar; bar.bar = (unsigned*)(a.ws + WS_CTL) + CW_BAR; bar.x = 0; bar.st = nullptr; bar.w0 = wid0 == 0;
    if (a.use_bar) bar = xcd_barrier_post((unsigned*)(a.ws + WS_CTL) + CW_BAR, MISC + 8, wid0 == 0);

#ifndef PROBE_PAR
#define PROBE_PAR 0
#endif
#ifndef PROBE_LATE
#define PROBE_LATE 0
#endif
#ifndef PROBE_REP_MASK
#define PROBE_REP_MASK 0
#endif
    int rep = 0;
#pragma unroll 1
    for (int p = a.ph_lo; p < a.ph_hi;) {
        int l = 0, st = 0, kind = K_PRO;
        if (p > 0) {
            const int q = p - 1;
            if (q < 7) { l = 0; st = q; } else if (q < 12) { l = 1; st = q - 7; } else if (q < 19) { l = 2; st = q - 12; } else { l = 3; st = q - 19; }
            if ((l & 1) == 0) kind = st == 0 ? K_G1H : st == 1 ? K_MIX : st == 2 ? K_H2 : st == 3 ? K_H3 : st == 4 ? K_G2 : st == 5 ? K_G3 : K_G4;
            else kind = st == 0 ? K_G1S : st == 1 ? K_MIX : st == 2 ? K_G2 : st == 3 ? K_G3 : K_G4;
        }
        int bid = bid0, G = G0; LAUNDER_S(bid); LAUNDER_S(G);
        const int j = l >> 1; const bool rebal = (G == 256);
        int wv_ = wid0; LAUNDER_S(wv_);
        int tid = wv_ * 64 + (int)xb_lane(); asm volatile("" : "+v"(tid));
        const int lane = tid & 63, wid = __builtin_amdgcn_readfirstlane(tid >> 6);
        GAS unsigned char* wsg_ = (GAS unsigned char*)a.ws; LAUNDER_S(wsg_); unsigned char* ws = (unsigned char*)wsg_;
        GAS float* outg_ = (GAS float*)a.out; LAUNDER_S(outg_); float* outp = (float*)outg_;
        float* const ssqb = (float*)(ws + WS_CTL) + CW_SSQ;
        float* const ssqp = (float*)(ws + WS_X);
#define SSQ_ARR(i_) ((i_) == 0 ? ssqb : ssqp + (size_t)((i_) - 1) * SSQ_SLABS * M)
#define SSQ_NSL(i_) ((i_) == 0 ? 1 : SSQ_SLABS)
        int kconv = 0;
        bool late = false; const int pb = (bid >> 4) * 8 + (bid & 7); const int kind0 = kind;
        const bool ovl = rebal && ((l & 1) ? SWA_LATE != 0 : HG_LATE != 0);
        if (ovl && kind == K_G2 && ((bid >> 3) & 1)) { kind = K_MIX; late = true; }
        switch (kind) {
        case K_PRO: phase_prologue(a, lds, tid, lane, wid, bid, G); break;
        case K_G1H: {
            pg8::Gemm g{(const bf16*)(ws + WS_XB), (const bf16*)(ws + WS_WINH) + (size_t)j * HG_IN * D, M, HG_IN, D}; pg8::StaticOrder S; S.init(M, HG_IN, G, bid);
            EpiHG E{SSQ_ARR(2 * l), SSQ_NSL(2 * l), (const float*)(ws + WS_SMALL) + j * 2048, ws + WS_P, (bf16*)(ws + WS_CQ)};
            pg8::gemm_phase<EpiHG, pg8::StaticOrder, true, true>(lds, g, S, E, tid);
            if (l == 0) {
                pg8::Gemm gm{(const bf16*)(ws + WS_MEMB), (const bf16*)(ws + WS_WMEM), 1024, 2048, D}; pg8::StaticOrder Sm; Sm.init(1024, 2048, G, (bid + 128) % G);
                EpiMem Em{(const float*)(ws + WS_SMALL + 16384), 1, INP(20), (bf16*)(ws + WS_MK), outp + O_MK};
                pg8::gemm_phase<EpiMem, pg8::StaticOrder, true, true>(lds, gm, Sm, Em, tid);
            }
            kconv = 1;
        } break;
        case K_MIX: case K_H2: {
            const bool hg = (l & 1) == 0, h2 = kind == K_H2;
            int rk = bid, nrk = G; if (late) { rk = pb; nrk = 128; }
            if (hg && !h2) {
                const bf16* VI = (const bf16*)(ws + WS_P + 2 * P_SLAB); const lf_t* ZF = (const lf_t*)(ws + WS_P + 4 * P_SLAB); const float* lbp = (const float*)(ws + WS_SMALL) + j * 2048;
                if (!late) { if (HG_PAIRS) hg_h1p_phase(lds, lbp, VI, ZF, (bf16*)(ws + WS_U), (float*)(ws + WS_DD), tid, lane, wid, bid, G); else hg_h1_phase(lds, lbp, VI, ZF, (bf16*)(ws + WS_U), (float*)(ws + WS_DD), tid, lane, wid, bid, G); }
                if (late || !ovl) hg_sample_phase(lds, lbp, (const bf16*)(ws + WS_P), VI, (const bf16*)(ws + WS_P + 3 * P_SLAB), ZF, INP(4) + (size_t)j * 128 * 6 * 16384, outp + O_HGS + (size_t)j * 128 * 6 * 16384, (bf16*)(ws + WS_ATT), tid, rk, nrk);
                __syncthreads();
            }
            if (h2) { if (HG_PAIRS) hg_h2p((const bf16*)(ws + WS_U), (const float*)(ws + WS_DD), (bf16*)(ws + WS_ST), outp + O_HGP + (size_t)j * 24 * 16384, bid * NTHR + tid); else hg_h2((const bf16*)(ws + WS_U), (const float*)(ws + WS_DD), (bf16*)(ws + WS_ST), outp + O_HGP + (size_t)j * 24 * 16384, bid * NTHR + tid); }
            AttnP P{ws, (const bf16*)(ws + WS_MK) + (size_t)l * 1024 * 256, INP(2) + (size_t)l * 128 * 65536, INP(3) + (size_t)l * 128 * 65536,
                    INP(5) + (size_t)j * 128 * 128 * 256, INP(6) + (size_t)j * 128 * 128 * 256, INP(17) + j * 12, outp + O_SKS + (size_t)j * 128 * 128 * 256};
            int ulo = 0, uhi = 1536, vlo = 0, vhi = 0;
            if (hg && rebal) {
                if (late) { ulo = 1024 + HG_MEM_KEEP; }
                else if (!h2) { ulo = 1024; uhi = ovl ? 1024 + HG_MEM_KEEP : 1536; }
                else { ulo = 768; uhi = 1024; }
            } else if (hg) { if (!h2) ulo = 768; else uhi = 0; }
            else if (ovl) {
                if (late) { ulo = 256 + SWA_KEEP; uhi = 768; vlo = 1024 + SWA_MEM_KEEP; vhi = 1536; }
                else { uhi = 256 + SWA_KEEP; vlo = 768; vhi = 1024 + SWA_MEM_KEEP; }
            }
            attn_phase(ulo, uhi, vlo, vhi, P, lds, tid, lane, wid, rk, nrk);
        } break;
        case K_H3: {
            if (HG_PAIRS) hg_h3p_phase(lds, (const float*)(ws + WS_SMALL) + j * 2048, (const bf16*)(ws + WS_P), (const bf16*)(ws + WS_P + 2 * P_SLAB), (const bf16*)(ws + WS_P + 3 * P_SLAB),
                        (const lf_t*)(ws + WS_P + 4 * P_SLAB), (const bf16*)(ws + WS_ST), (bf16*)(ws + WS_ATT), tid, lane, wid, bid, G);
            else hg_h3_phase(lds, (const float*)(ws + WS_SMALL) + j * 2048, (const bf16*)(ws + WS_P), (const bf16*)(ws + WS_P + 2 * P_SLAB), (const bf16*)(ws + WS_P + 3 * P_SLAB),
                        (const lf_t*)(ws + WS_P + 4 * P_SLAB), (const bf16*)(ws + WS_ST), (bf16*)(ws + WS_ATT), tid, lane, wid, bid, G);
        } break;
        case K_G1S: {
            pg8::Gemm g{(const bf16*)(ws + WS_XB), (const bf16*)(ws + WS_WINS) + (size_t)j * SW_IN * D, M, SW_IN, D}; pg8::StaticOrder S; S.init(M, SW_IN, G, bid);
            EpiSW E{SSQ_ARR(2 * l), SSQ_NSL(2 * l), (const float*)(ws + WS_SMALL + 32768) + j * 256, ws, outp, j};
            pg8::gemm_phase<EpiSW, pg8::StaticOrder, true, true>(lds, g, S, E, tid);
            kconv = 1;
        } break;
        case K_G2: case K_G4: {
            const bool g4 = kind == K_G4, fin = g4 && l == 3;
            const bf16* Ap = (const bf16*)(ws + (g4 ? WS_P : WS_ATT));
            const bf16* Bp = (const bf16*)(ws + (g4 ? WS_WFF2 + (size_t)l * D * DFF * 2 : WS_WOUT + (size_t)l * D * D * 2));
            pg8::Gemm g{Ap, Bp, M, D, g4 ? DFF : D};
            const bool halfg = ovl && !g4;
            pg8::StaticOrder S; S.init(rebal ? MP : M, D, halfg ? 128 : G, halfg ? pb : bid);
            float* yo = nullptr; if (fin) yo = outp + O_Y;
            EpiRes E{(bf16*)(ws + WS_XB), yo, SSQ_ARR(2 * l + (g4 ? 2 : 1))};
            pg8::gemm_phase<EpiRes, pg8::StaticOrder, true, true>(lds, g, S, E, tid);
        } break;
        case K_G3: {
            pg8::Gemm g{(const bf16*)(ws + WS_XB), (const bf16*)(ws + WS_WFF1) + (size_t)l * NFF1 * D, M, NFF1, D};
            const bool swa = true;
            unsigned* cntA = (unsigned*)(ws + WS_CTL) + CW_CNT + 1024 + 128 * l;
            if (rebal && swa && bid >= 248 && rep == 0) {
                const int sidx = bid - 248, panel = sidx >> 2;
                pg8::Gemm g2{(const bf16*)(ws + WS_ATT), (const bf16*)(ws + WS_WOUT) + (size_t)l * D * D, M, D, D};
                OneUnit S2{64 + panel, sidx & 3, cntA + 64 * panel};
                EpiRes E2{(bf16*)(ws + WS_XB), nullptr, SSQ_ARR(2 * l + 1)};
                pg8::gemm_phase<EpiRes, OneUnit, true, true>(lds, g2, S2, E2, tid);
                __syncthreads();
            }
            OrderG3 S; S.c = bid; S.rebal = rebal; S.cnt = (unsigned*)(ws + WS_CTL) + CW_CNT + 128 * l; S.swa = swa; S.cntA = cntA; S.w0 = wid == 0; S.so.init(rebal ? MP : M, NFF1, G, bid);
            EpiFF1 E{SSQ_ARR(2 * l + 1), SSQ_SLABS, (bf16*)(ws + WS_P)};
            pg8::gemm_phase<EpiFF1, OrderG3, true, true>(lds, g, S, E, tid);
        } break;
        default: break;
        }
        {
            int cvL = -1, lo = 0, hi = 0, first = 0, last = G;
            if (G == 256) {
                if (kind == K_G1H && l == 0) { cvL = 1; lo = 0; hi = 3300; first = 160; last = 256; }
                else if (kind == K_H2 && l == 0) { cvL = 1; lo = 3300; hi = 4600; first = 192; last = 248; }
                else if (kind == K_G3 && l == 0) { cvL = 1; lo = 4600; hi = 5504; first = G3_SWAP ? 152 : 204; last = G3_SWAP ? 196 : 248; }
                else if (kind == K_G1S && l == 1) { cvL = 2; lo = 0; hi = 5000; first = 140; last = 256; }
                else if (kind == K_G3 && l == 1) { cvL = 2; lo = 5000; hi = 6400; first = G3_SWAP ? 152 : 204; last = G3_SWAP ? 196 : 248; }
                else if (kind == K_G1H && l == 2) { cvL = 3; lo = 0; hi = 5504; first = 90; last = 256; }
            } else if (kconv && l < 3) { cvL = l + 1; lo = 0; hi = layer_items(l + 1); }
            if (cvL >= 0 && bid >= first && bid < last) { __syncthreads(); convert_weights(a, ws, lds, cvL, lo, hi, false, (bid - first) * NWAVES + wid, (last - first) * NWAVES, wid, lane); }
        }
        if (rebal && bid >= 248 && kind == K_G3 && rep == 0) {
            const bool g4 = kind == K_G3, fin = g4 && l == 3;
            const int sidx = bid - 248, panel = sidx >> 2;
            if (g4) {
                if (wid == 0) {
                    unsigned* cw = (unsigned*)(ws + WS_CTL) + CW_CNT + 128 * l + 64 * panel; unsigned sp = 0;
                    while ((unsigned)__builtin_amdgcn_readfirstlane(__hip_atomic_load(cw, __ATOMIC_RELAXED, __HIP_MEMORY_SCOPE_AGENT)) < 176u) { __builtin_amdgcn_s_sleep(8); if (++sp > (1u << 22)) break; }
                    __builtin_amdgcn_fence(__ATOMIC_ACQUIRE, "agent");
                    asm volatile("s_waitcnt vmcnt(0)" ::: "memory");
                }
                __syncthreads();
            }
            const bf16* Ap = (const bf16*)(ws + (g4 ? WS_P : WS_ATT));
            const bf16* Bp = (const bf16*)(ws + (g4 ? WS_WFF2 + (size_t)l * D * DFF * 2 : WS_WOUT + (size_t)l * D * D * 2));
            pg8::Gemm g{Ap, Bp, M, D, g4 ? DFF : D};
            OneUnit S{64 + panel, sidx & 3, nullptr};
            float* yo = nullptr; if (fin) yo = outp + O_Y;
            EpiRes E{(bf16*)(ws + WS_XB), yo, SSQ_ARR(2 * l + (g4 ? 2 : 1))};
            pg8::gemm_phase<EpiRes, OneUnit, true, true>(lds, g, S, E, tid);
        }
        if (PROBE_LATE != 0 && late && rep == 0 && ((PROBE_LATE == 1 && (l & 1)) || (PROBE_LATE == 2 && !(l & 1)))) { rep = 1; __syncthreads(); continue; }
        if (PROBE_REP_MASK != 0 && rep == 0 && ((PROBE_REP_MASK >> kind0) & 1) && (PROBE_PAR == 0 || (PROBE_PAR == 1 && (l & 1)) || (PROBE_PAR == 2 && !(l & 1)))) { rep = 1; if (a.use_bar) xcd_barrier(bar); else __syncthreads(); continue; }
        rep = 0; ++p;
        if (p < a.ph_hi) { if (a.use_bar) xcd_barrier(bar); else __syncthreads(); }
    }
}

extern "C" void kernel_launch(void* const* d_in, const int* in_sizes, int n_in, void* d_out, int out_size, void* d_ws, size_t ws_size, hipStream_t stream) {
    static int grid = 0;
    if (grid == 0) {
        if (n_in != 24 || ws_size < WS_END) { fprintf(stderr, "kernel_launch: unexpected n_in %d or ws_size %zu (need %zu)\n", n_in, ws_size, (size_t)WS_END); grid = -1; return; }
        int dev = 0, cus = 0;
        if (hipGetDevice(&dev) != hipSuccess || hipDeviceGetAttribute(&cus, hipDeviceAttributeMultiprocessorCount, dev) != hipSuccess) { grid = -1; return; }
        if (hipFuncSetAttribute((const void*)fwd_kernel, hipFuncAttributeMaxDynamicSharedMemorySize, LDS_BYTES) != hipSuccess) { fprintf(stderr, "kernel_launch: hipFuncSetAttribute failed\n"); grid = -1; return; }
        int per_cu = 0;
        if (hipOccupancyMaxActiveBlocksPerMultiprocessor(&per_cu, (const void*)fwd_kernel, NTHR, LDS_BYTES) != hipSuccess || per_cu < 1) fprintf(stderr, "kernel_launch: occupancy query says %d blocks/CU\n", per_cu);
        (void)hipGetLastError();
        grid = cus;
    }
    if (grid < 0) return;
    (void)hipMemsetAsync((char*)d_ws + WS_CTL, 0, CTL_ZERO_BYTES, stream);
    Args a{};
    for (int i = 0; i < 24; ++i) a.in[i] = (const float*)d_in[i];
    a.out = (float*)d_out; a.ws = (unsigned char*)d_ws;
#if MK_PER_PHASE
    for (int p = 0; p < N_PHASES; ++p) { a.ph_lo = p; a.ph_hi = p + 1; a.use_bar = 0; hipLaunchKernelGGL(fwd_kernel, dim3(grid), dim3(NTHR), LDS_BYTES, stream, a); }
#else
    a.ph_lo = 0; a.ph_hi = N_PHASES; a.use_bar = 1;
    hipLaunchKernelGGL(fwd_kernel, dim3(grid), dim3(NTHR), LDS_BYTES, stream, a);
#endif
}
```
